# Optimizing an MI355X kernel written in HIP

```python
import math
import jax, jax.numpy as jnp
from jax import lax
import numpy as np

D_MODEL = 1024
BATCH = 8
SEQ = 4096
DEPTH = 4

GRID_W = 64
CTX_LEN = 256
N_MIXERS = 4
EPS = 1e-6
Q_BLOCK = 128
N_MOD = 6

MLA_HEADS = 16
MLA_Q_RANK = 384
MLA_KV_RANK = 256
MLA_NOPE_DIM = 64
MLA_ROPE_DIM = 32
MLA_V_DIM = 64
MLA_QK_DIM = MLA_NOPE_DIM + MLA_ROPE_DIM
ROPE_THETA = 10000.0

S5_WIDTH = D_MODEL // 2
S5_GROUP_CH = 16
S5_GROUPS = S5_WIDTH // S5_GROUP_CH
S5_STATE = 64
S5_DT_MIN = 1e-3
S5_DT_MAX = 1e-1

HG_HEAD_DIM = 128
HG_HEADS = D_MODEL // HG_HEAD_DIM
HG_CHUNK = 64

NA_HEADS = 16
NA_HEAD_DIM = D_MODEL // NA_HEADS
NA_KH = 8
NA_KW = 16

FFN_DIM = ((8 * D_MODEL // 3 + 255) // 256) * 256

kernel_name = "hybrid_interleaved_diffusion_trunk"

F32 = jnp.float32


def rms_norm(x, g):
    xf = x.astype(F32)
    y = xf * lax.rsqrt(jnp.mean(xf * xf, axis=-1, keepdims=True) + EPS)
    return (y * g.astype(F32)).astype(x.dtype)


def modulate(x, shift, scale):
    return x * (1 + scale) + shift


def _flip(t):
    return jnp.flip(t, axis=1)


def _ident(t):
    return t


def blocked_attention(q, k, v, scale):
    bsz, lq, h, dk = q.shape
    qb = jnp.moveaxis(q.reshape(bsz, lq // Q_BLOCK, Q_BLOCK, h, dk), 1, 0)

    def attend(qblk):
        s = jnp.einsum("bqhd,bkhd->bhqk", qblk, k, preferred_element_type=F32) * scale
        p = jax.nn.softmax(s, axis=-1).astype(v.dtype)
        return jnp.einsum("bhqk,bkhd->bqhd", p, v)

    o = lax.map(attend, qb)
    return jnp.moveaxis(o, 0, 1).reshape(bsz, lq, h, v.shape[-1])


def rope_rotate(v, pos):
    half = v.shape[-1] // 2
    inv = 1.0 / (ROPE_THETA ** (jnp.arange(half, dtype=F32) / half))
    ang = pos.astype(F32)[:, None] * inv[None, :]
    cos = jnp.cos(ang)[None, :, None, :]
    sin = jnp.sin(ang)[None, :, None, :]
    vf = v.astype(F32)
    v1, v2 = vf[..., :half], vf[..., half:]
    return jnp.concatenate([v1 * cos - v2 * sin, v1 * sin + v2 * cos], axis=-1).astype(v.dtype)


def axial_rope_2d(x):
    t = jnp.arange(x.shape[1])
    a = MLA_ROPE_DIM // 2
    return jnp.concatenate([rope_rotate(x[..., :a], t // GRID_W),
                            rope_rotate(x[..., a:], t % GRID_W)], axis=-1)


def mla_project(u, w_in, q_norm_g, w_q_up, kv_norm_g, w_kv_up):
    bsz, n, _ = u.shape
    lat = u @ w_in
    q_lat = lat[..., :MLA_Q_RANK]
    kv_lat = lat[..., MLA_Q_RANK:MLA_Q_RANK + MLA_KV_RANK]
    k_rope = lat[..., MLA_Q_RANK + MLA_KV_RANK:][:, :, None, :]
    q = (rms_norm(q_lat, q_norm_g) @ w_q_up).reshape(bsz, n, MLA_HEADS, MLA_QK_DIM)
    kv = (rms_norm(kv_lat, kv_norm_g) @ w_kv_up).reshape(bsz, n, MLA_HEADS, MLA_NOPE_DIM + MLA_V_DIM)
    return q[..., :MLA_NOPE_DIM], q[..., MLA_NOPE_DIM:], kv[..., :MLA_NOPE_DIM], k_rope, kv[..., MLA_NOPE_DIM:]


def mla_mixer(u, uc, w_in, q_norm_g, w_q_up, kv_norm_g, w_kv_up, w_out, with_ctx_out):
    bsz, n, _ = u.shape
    qn, qr, kn, kr, v = mla_project(u, w_in, q_norm_g, w_q_up, kv_norm_g, w_kv_up)
    qr, kr = axial_rope_2d(qr), axial_rope_2d(kr)
    q = jnp.concatenate([qn, qr], axis=-1)
    k = jnp.concatenate([kn, jnp.broadcast_to(kr, qr.shape)], axis=-1)
    qnc, qrc, knc, krc, vc = mla_project(uc, w_in, q_norm_g, w_q_up, kv_norm_g, w_kv_up)
    kc = jnp.concatenate([knc, jnp.broadcast_to(krc, qrc.shape)], axis=-1)
    scale = MLA_QK_DIM ** -0.5
    o = blocked_attention(q, jnp.concatenate([kc, k], axis=1), jnp.concatenate([vc, v], axis=1), scale)
    y = o.reshape(bsz, n, MLA_HEADS * MLA_V_DIM) @ w_out
    yc = None
    if with_ctx_out:
        oc = blocked_attention(jnp.concatenate([qnc, qrc], axis=-1), kc, vc, scale)
        yc = oc.reshape(bsz, uc.shape[1], MLA_HEADS * MLA_V_DIM) @ w_out
    return y, yc


def s5_discretize(lam_re, lam_im, log_dt, b_re, b_im):
    lam = lax.complex(lam_re.astype(F32), lam_im.astype(F32))
    dt = jnp.exp(log_dt.astype(F32))[:, None]
    lam_bar = jnp.exp(lam * dt)
    b_mat = lax.complex(b_re.astype(F32), b_im.astype(F32))
    b_bar = ((lam_bar - 1.0) / lam)[..., None] * b_mat
    return lam_bar, b_bar


def diagonal_scan(lam_bar, bu, h0):
    bu = bu.at[:, 0].add(lam_bar * h0)
    a = jnp.broadcast_to(lam_bar, (1,) + bu.shape[1:])

    def combine(left, right):
        a_l, b_l = left
        a_r, b_r = right
        return a_r * a_l, a_r * b_l + b_r

    return lax.associative_scan(combine, (a, bu), axis=1)[1]


def s5_mixer(u, uc, w_in, lam_re, lam_im, log_dt, b_re, b_im, c_re, c_im, d_skip, w_glu, with_ctx_out):
    z = (u @ w_in).astype(F32)
    zc = (uc @ w_in).astype(F32)

    def grp(t):
        return t.reshape(t.shape[0], t.shape[1], S5_GROUPS, S5_GROUP_CH)

    dsk = d_skip.astype(F32)
    y = z * dsk
    yc = zc * dsk
    for d in range(2):
        fl = _flip if d == 1 else _ident
        lam_bar, b_bar = s5_discretize(lam_re[d], lam_im[d], log_dt[d], b_re[d], b_im[d])
        c_mat = lax.complex(c_re[d].astype(F32), c_im[d].astype(F32))
        h0 = jnp.zeros((zc.shape[0], S5_GROUPS, S5_STATE), jnp.complex64)
        hc = diagonal_scan(lam_bar, jnp.einsum("gnc,blgc->blgn", b_bar, grp(fl(zc))), h0)
        h = diagonal_scan(lam_bar, jnp.einsum("gnc,blgc->blgn", b_bar, grp(fl(z))), hc[:, -1])
        y = y + fl(jnp.real(jnp.einsum("gcn,blgn->blgc", c_mat, h))).reshape(z.shape)
        if with_ctx_out:
            yc = yc + fl(jnp.real(jnp.einsum("gcn,blgn->blgc", c_mat, hc))).reshape(zc.shape)

    def glu(t):
        a, g = jnp.split(jax.nn.gelu(t).astype(u.dtype) @ w_glu, 2, axis=-1)
        return a * jax.nn.sigmoid(g)

    return glu(y), (glu(yc) if with_ctx_out else None)


def gla_chunkwise(q, k, v, log_f, s0):
    bsz, n, h, dk = q.shape
    dv = v.shape[-1]
    nc = n // HG_CHUNK

    def blk(t):
        return t.reshape(bsz, nc, HG_CHUNK, h, t.shape[-1])

    q, k, v, log_f = blk(q), blk(k), blk(v), blk(log_f)
    b = jnp.cumsum(log_f, axis=2)
    b_last = b[:, :, -1:]
    q_in = q * jnp.exp(b)
    k_in = k * jnp.exp(-b)
    k_out = k * jnp.exp(b_last - b)
    att = jnp.einsum("bcthd,bcshd->bchts", q_in, k_in)
    incl = jnp.tril(jnp.ones((HG_CHUNK, HG_CHUNK), dtype=bool))
    att = jnp.where(incl, att, 0.0)
    o = jnp.einsum("bchts,bcshv->bcthv", att, v)
    ds = jnp.einsum("bcshd,bcshv->cbhdv", k_out, v)
    decay = jnp.moveaxis(jnp.exp(b_last[:, :, 0]), 1, 0)

    def step(s, inp):
        dec, d_s = inp
        return dec[..., None] * s + d_s, s

    s_final, s_start = lax.scan(step, s0, (decay, ds))
    o = o + jnp.einsum("bcthd,cbhdv->bcthv", q_in, s_start)
    return o.reshape(bsz, n, h, dv), s_final


def hgrn2_mixer(u, uc, w_in, lower_bound, norm_g, w_out, with_ctx_out):
    lb = lower_bound.astype(F32).reshape(HG_HEADS, HG_HEAD_DIM)

    def prep(t):
        z = (t @ w_in).astype(F32).reshape(t.shape[0], t.shape[1], 5, HG_HEADS, HG_HEAD_DIM)
        q = jax.nn.silu(z[:, :, 0]) * HG_HEAD_DIM ** -0.5
        forget = lb + (1.0 - lb) * jax.nn.sigmoid(z[:, :, 1:3])
        return q, 1.0 - forget, jnp.log(forget), z[:, :, 3], z[:, :, 4]

    q, k, log_f, v, g = prep(u)
    qc, kc, log_fc, vc, gc = prep(uc)
    o = jnp.zeros_like(v)
    oc = jnp.zeros_like(vc)
    for d in range(2):
        fl = _flip if d == 1 else _ident
        s0 = jnp.zeros((uc.shape[0], HG_HEADS, HG_HEAD_DIM, HG_HEAD_DIM), F32)
        oc_d, s_ctx = gla_chunkwise(fl(qc), fl(kc[:, :, d]), fl(vc), fl(log_fc[:, :, d]), s0)
        o_d, _ = gla_chunkwise(fl(q), fl(k[:, :, d]), fl(v), fl(log_f[:, :, d]), s_ctx)
        o = o + fl(o_d)
        if with_ctx_out:
            oc = oc + fl(oc_d)

    def readout(o_h, g_h):
        on = o_h * lax.rsqrt(jnp.mean(o_h * o_h, axis=-1, keepdims=True) + EPS)
        shp = (o_h.shape[0], o_h.shape[1], D_MODEL)
        on = on.reshape(shp) * norm_g.astype(F32) * jax.nn.silu(g_h.reshape(shp))
        return on.astype(u.dtype) @ w_out

    return readout(o, g), (readout(oc, gc) if with_ctx_out else None)


def natten_mixer(u, uc, w_qkv, rpb, w_out, with_ctx_out):
    bsz, n, _ = u.shape
    rows = n // GRID_W
    kh = min(NA_KH, rows)
    n_loc = kh * NA_KW

    def heads(t):
        return t.reshape(t.shape[0], t.shape[1], NA_HEADS, NA_HEAD_DIM)

    q, k, v = (heads(t) for t in jnp.split(u @ w_qkv, 3, axis=-1))
    qc, kc, vc = (heads(t) for t in jnp.split(uc @ w_qkv, 3, axis=-1))
    scale = NA_HEAD_DIM ** -0.5

    def grid(t):
        return t.reshape(bsz, rows, GRID_W, NA_HEADS, NA_HEAD_DIM)

    qg, kg, vg = grid(q), grid(k), grid(v)
    col = jnp.arange(GRID_W)
    col_idx = jnp.clip(col - NA_KW // 2, 0, GRID_W - NA_KW)[:, None] + jnp.arange(NA_KW)[None, :]
    col_off = col_idx - col[:, None] + (NA_KW - 1)

    def row_block(r):
        r0 = jnp.clip(r - kh // 2, 0, rows - kh)
        k_win = lax.dynamic_slice_in_dim(kg, r0, kh, axis=1)[:, :, col_idx]
        v_win = lax.dynamic_slice_in_dim(vg, r0, kh, axis=1)[:, :, col_idx]
        q_row = lax.dynamic_index_in_dim(qg, r, axis=1, keepdims=False)
        row_off = r0 + jnp.arange(kh) - r + (NA_KH - 1)
        bias = rpb[:, row_off[:, None, None], col_off[None, :, :]]
        s_loc = jnp.einsum("bwhd,brwchd->bhwrc", q_row, k_win, preferred_element_type=F32) * scale
        s_loc = s_loc + jnp.transpose(bias, (0, 2, 1, 3))[None].astype(F32)
        s_ctx = jnp.einsum("bwhd,bjhd->bhwj", q_row, kc, preferred_element_type=F32) * scale
        s = jnp.concatenate([s_loc.reshape(bsz, NA_HEADS, GRID_W, n_loc), s_ctx], axis=-1)
        p = jax.nn.softmax(s, axis=-1).astype(v.dtype)
        p_loc = p[..., :n_loc].reshape(bsz, NA_HEADS, GRID_W, kh, NA_KW)
        return (jnp.einsum("bhwrc,brwchd->bwhd", p_loc, v_win)
                + jnp.einsum("bhwj,bjhd->bwhd", p[..., n_loc:], vc))

    o = lax.map(row_block, jnp.arange(rows))
    y = jnp.moveaxis(o, 0, 1).reshape(bsz, n, D_MODEL) @ w_out
    yc = None
    if with_ctx_out:
        yc = blocked_attention(qc, kc, vc, scale).reshape(bsz, uc.shape[1], D_MODEL) @ w_out
    return y, yc


def conv_ffn(u, w_up, conv_w, conv_b, w_down):
    h = u @ w_up
    hp = jnp.pad(h, ((0, 0), (1, 1), (0, 0)))
    h = hp[:, :-2] * conv_w[0] + hp[:, 1:-1] * conv_w[1] + hp[:, 2:] * conv_w[2] + conv_b
    a, g = jnp.split(h, 2, axis=-1)
    return (a * jax.nn.silu(g)) @ w_down


def setup_inputs(seed: int = 0) -> dict:
    key = jax.random.key(seed)
    ks = jax.random.split(key, 36)

    def nrm(i, shape, s):
        return jax.random.normal(ks[i], shape, F32) * s

    def gain(i, shape):
        return 1.0 + nrm(i, shape, 0.02)

    na, nb, nc, nd = (len(range(kind, DEPTH, N_MIXERS)) for kind in range(N_MIXERS))
    n_idx = jnp.arange(S5_STATE, dtype=F32)
    d = D_MODEL
    return {
        "x": nrm(0, (BATCH, SEQ, d), 1.0),
        "c": nrm(1, (BATCH, d), 1.0),
        "ctx": nrm(2, (BATCH, CTX_LEN, d), 1.0),
        "c_ctx": nrm(3, (d,), 1.0),
        "ada_w": nrm(4, (DEPTH, d, N_MOD * d), 0.5 * d ** -0.5),
        "ada_b": nrm(5, (DEPTH, N_MOD * d), 0.02),
        "norm1_g": gain(6, (DEPTH, d)),
        "norm2_g": gain(7, (DEPTH, d)),
        "mla_w_in": nrm(8, (na, d, MLA_Q_RANK + MLA_KV_RANK + MLA_ROPE_DIM), d ** -0.5),
        "mla_q_norm_g": gain(9, (na, MLA_Q_RANK)),
        "mla_w_q_up": nrm(10, (na, MLA_Q_RANK, MLA_HEADS * MLA_QK_DIM), MLA_Q_RANK ** -0.5),
        "mla_kv_norm_g": gain(11, (na, MLA_KV_RANK)),
        "mla_w_kv_up": nrm(12, (na, MLA_KV_RANK, MLA_HEADS * (MLA_NOPE_DIM + MLA_V_DIM)), MLA_KV_RANK ** -0.5),
        "mla_w_out": nrm(13, (na, MLA_HEADS * MLA_V_DIM, d), (MLA_HEADS * MLA_V_DIM) ** -0.5),
        "s5_w_in": nrm(14, (nb, d, S5_WIDTH), d ** -0.5),
        "s5_lambda_re": -0.5 + nrm(15, (nb, 2, S5_GROUPS, S5_STATE), 0.01),
        "s5_lambda_im": math.pi * n_idx + nrm(16, (nb, 2, S5_GROUPS, S5_STATE), 0.01),
        "s5_log_dt": jax.random.uniform(ks[17], (nb, 2, S5_GROUPS), F32,
                                        minval=math.log(S5_DT_MIN), maxval=math.log(S5_DT_MAX)),
        "s5_b_re": nrm(18, (nb, 2, S5_GROUPS, S5_STATE, S5_GROUP_CH), (2 * S5_GROUP_CH) ** -0.5),
        "s5_b_im": nrm(19, (nb, 2, S5_GROUPS, S5_STATE, S5_GROUP_CH), (2 * S5_GROUP_CH) ** -0.5),
        "s5_c_re": nrm(20, (nb, 2, S5_GROUPS, S5_GROUP_CH, S5_STATE), S5_STATE ** -0.5),
        "s5_c_im": nrm(21, (nb, 2, S5_GROUPS, S5_GROUP_CH, S5_STATE), S5_STATE ** -0.5),
        "s5_d": nrm(22, (nb, S5_WIDTH), 1.0),
        "s5_w_glu": nrm(23, (nb, S5_WIDTH, 2 * d), S5_WIDTH ** -0.5),
        "hg_w_in": nrm(24, (nc, d, 5 * d), d ** -0.5),
        "hg_lower_bound": nrm(25, (DEPTH, HG_HEADS * HG_HEAD_DIM), 0.1),
        "hg_norm_g": gain(26, (nc, d)),
        "hg_w_out": nrm(27, (nc, d, d), d ** -0.5),
        "na_w_qkv": nrm(28, (nd, d, 3 * d), d ** -0.5),
        "na_rpb": nrm(29, (nd, NA_HEADS, 2 * NA_KH - 1, 2 * NA_KW - 1), 0.1),
        "na_w_out": nrm(30, (nd, d, d), d ** -0.5),
        "ffn_w_up": nrm(31, (DEPTH, d, 2 * FFN_DIM), d ** -0.5),
        "ffn_conv_w": nrm(32, (DEPTH, 3, 2 * FFN_DIM), 3 ** -0.5),
        "ffn_conv_b": nrm(33, (DEPTH, 2 * FFN_DIM), 0.02),
        "ffn_w_down": nrm(34, (DEPTH, FFN_DIM, d), FFN_DIM ** -0.5),
        "final_g": gain(35, (d,)),
    }


def reference(x, c, ctx, c_ctx, ada_w, ada_b, norm1_g, norm2_g,
              mla_w_in, mla_q_norm_g, mla_w_q_up, mla_kv_norm_g, mla_w_kv_up, mla_w_out,
              s5_w_in, s5_lambda_re, s5_lambda_im, s5_log_dt, s5_b_re, s5_b_im, s5_c_re, s5_c_im,
              s5_d, s5_w_glu,
              hg_w_in, hg_lower_bound, hg_norm_g, hg_w_out,
              na_w_qkv, na_rpb, na_w_out,
              ffn_w_up, ffn_conv_w, ffn_conv_b, ffn_w_down,
              final_g):
    lb_cum = jnp.cumsum(jax.nn.softmax(hg_lower_bound.astype(F32), axis=0), axis=0)
    lower_bounds = lb_cum - lb_cum[0]
    cond = jax.nn.silu(c)
    cond_ctx = jax.nn.silu(c_ctx)
    h_ctx = ctx
    for i in range(DEPTH):
        kind, j = i % N_MIXERS, i // N_MIXERS
        with_ctx_out = i < DEPTH - 1
        mod = cond @ ada_w[i] + ada_b[i]
        mod_c = cond_ctx @ ada_w[i] + ada_b[i]
        sh1, sc1, g1, sh2, sc2, g2 = jnp.split(mod[:, None, :], N_MOD, axis=-1)
        csh1, csc1, cg1, csh2, csc2, cg2 = jnp.split(mod_c, N_MOD, axis=-1)
        u = modulate(rms_norm(x, norm1_g[i]), sh1, sc1)
        uc = modulate(rms_norm(h_ctx, norm1_g[i]), csh1, csc1)
        if kind == 0:
            y, yc = mla_mixer(u, uc, mla_w_in[j], mla_q_norm_g[j], mla_w_q_up[j], mla_kv_norm_g[j],
                              mla_w_kv_up[j], mla_w_out[j], with_ctx_out)
        elif kind == 1:
            y, yc = s5_mixer(u, uc, s5_w_in[j], s5_lambda_re[j], s5_lambda_im[j], s5_log_dt[j],
                             s5_b_re[j], s5_b_im[j], s5_c_re[j], s5_c_im[j], s5_d[j], s5_w_glu[j],
                             with_ctx_out)
        elif kind == 2:
            y, yc = hgrn2_mixer(u, uc, hg_w_in[j], lower_bounds[i], hg_norm_g[j], hg_w_out[j], with_ctx_out)
        else:
            y, yc = natten_mixer(u, uc, na_w_qkv[j], na_rpb[j], na_w_out[j], with_ctx_out)
        x = x + g1 * y
        x = x + g2 * conv_ffn(modulate(rms_norm(x, norm2_g[i]), sh2, sc2),
                              ffn_w_up[i], ffn_conv_w[i], ffn_conv_b[i], ffn_w_down[i])
        if with_ctx_out:
            h_ctx = h_ctx + cg1 * yc
            h_ctx = h_ctx + cg2 * conv_ffn(modulate(rms_norm(h_ctx, norm2_g[i]), csh2, csc2),
                                           ffn_w_up[i], ffn_conv_w[i], ffn_conv_b[i], ffn_w_down[i])
    return rms_norm(x, final_g)
```

```cpp
#include <hip/hip_runtime.h>
#include <hip/hip_bf16.h>
#include <hip/hip_fp16.h>
#include <hip/hip_cooperative_groups.h>
#include <cstdio>
#include <cstring>
namespace cg = cooperative_groups;

#ifndef ONE_LAUNCH
#define ONE_LAUNCH 1
#endif

typedef __attribute__((ext_vector_type(8))) short bf16x8;
typedef __attribute__((ext_vector_type(4))) short bf16x4;
typedef __attribute__((ext_vector_type(4))) float f32x4;
typedef unsigned short u16;

constexpr int NB = 8, SEQ = 4096, CTX = 256, PB = 4352, T_ = 34816, D_ = 1024;
constexpr int F_ = 2816, F2 = 5632;
constexpr int HR = 17408;
constexpr float EPS = 1e-6f;
constexpr float LOG2E = 1.4426950408889634f;

struct TDesc { const float* src; u16* dst; int K, N, Npad, mode; };

struct Params {
  const float* in[36];
  float* out;
  float* X; u16* U; float* mod; float* cs; float* lb2; float* lamb; float* bbar;
  u16* w_mla_in; u16* w_mla_q; u16* w_mla_kv; u16* w_mla_out;
  u16* w_s5_in; u16* w_s5_glu; u16* w_hg_in; u16* w_hg_out; u16* w_na_qkv; u16* w_na_out;
  u16* w_up[4]; u16* w_down[4];
  float* lat; u16* Qm; u16* Kn; u16* Vm; u16* qn; u16* kvn; u16* kr;
  float* z; float* yd; float* chst;
  u16* hq; u16* hlf; u16* hv; u16* hsg; u16* ho;
  u16* QKV;
  u16* H; u16* act;
  TDesc td[20];
  int ntd; int ntt;
};

__device__ __forceinline__ int tidx() { int t = threadIdx.x; asm volatile("" : "+v"(t)); return t; }
__device__ __forceinline__ int bidx() { int t = blockIdx.x; asm volatile("" : "+s"(t)); return t; }
__device__ __forceinline__ u16 f2bf(float f) {
  unsigned u = __float_as_uint(f);
  u += 0x7fffu + ((u >> 16) & 1u);
  return (u16)(u >> 16);
}
__device__ __forceinline__ float bf2f(u16 h) { return __uint_as_float(((unsigned)h) << 16); }
__device__ __forceinline__ float sigmoidf_(float x) { return 1.f / (1.f + __expf(-x)); }
__device__ __forceinline__ float siluf_(float x) { return x / (1.f + __expf(-x)); }
__device__ __forceinline__ float geluf_(float x) {
  float u = 0.7978845608028654f * (x + 0.044715f * x * x * x);
  return 0.5f * x * (1.f + tanhf(u));
}
__device__ __forceinline__ float wave_sum(float v) {
#pragma unroll
  for (int o = 32; o > 0; o >>= 1) v += __shfl_xor(v, o);
  return v;
}
__device__ __forceinline__ int brow_of(int row) {
  int b = row / PB; int pp = row - b * PB;
  return pp < CTX ? 8 : b;
}
__device__ __forceinline__ int pos_of(int d, int s) {
  return d == 0 ? s : (s < CTX ? (CTX - 1 - s) : (PB + CTX - 1 - s));
}

__device__ __forceinline__ int glu_map(int np) {
  int tile = np >> 7, c = np & 127;
  int wn = c >> 6, s = (c & 63) >> 4;
  int f = tile * 64 + 32 * wn + 16 * (s & 1) + (c & 15);
  return f + ((s >= 2) ? 1024 : 0);
}

__device__ __forceinline__ void prep_transpose(const Params& p, int item, float* ts) {
  int di = 0, rem = item;
  for (; di < p.ntd; ++di) {
    int nt = (p.td[di].K >> 6) * (p.td[di].Npad >> 6);
    if (rem < nt) break;
    rem -= nt;
  }
  const TDesc& t = p.td[di];
  int ntn = t.Npad >> 6;
  int kk0 = (rem / ntn) * 64, n0 = (rem % ntn) * 64;
  int tid = tidx();
#pragma unroll
  for (int i = 0; i < 4; ++i) {
    int kl = (tid >> 4) + 16 * i;
    int nl = (tid & 15) * 4;
    int np = n0 + nl;
    int sc = (t.mode == 1) ? glu_map(np) : np;
    float4 v = make_float4(0.f, 0.f, 0.f, 0.f);
    if (np < t.N) v = *(const float4*)(t.src + (size_t)(kk0 + kl) * t.N + sc);
    ts[(nl + 0) * 65 + kl] = v.x; ts[(nl + 1) * 65 + kl] = v.y;
    ts[(nl + 2) * 65 + kl] = v.z; ts[(nl + 3) * 65 + kl] = v.w;
  }
  __syncthreads();
  {
    int nl = tid >> 2, kq = (tid & 3) * 16;
    bf16x8 o0, o1;
#pragma unroll
    for (int e = 0; e < 8; ++e) { o0[e] = (short)f2bf(ts[nl * 65 + kq + e]); o1[e] = (short)f2bf(ts[nl * 65 + kq + 8 + e]); }
    u16* d = t.dst + (size_t)(n0 + nl) * t.K + kk0 + kq;
    *(bf16x8*)d = o0; *(bf16x8*)(d + 8) = o1;
  }
  __syncthreads();
}

__device__ __forceinline__ void prep_mod(const Params& p, int item, float* sm) {
  int i = item / 96, cc = item % 96;
  float* sc = sm;
  float* red = sm + 9 * 1024;
  int tid = tidx();
  for (int e = tid; e < 9 * 1024; e += 256) {
    int r = e >> 10, k = e & 1023;
    float v = (r < 8) ? p.in[1][r * 1024 + k] : p.in[3][k];
    sc[e] = siluf_(v);
  }
  __syncthreads();
  int kq = tid >> 6, col = tid & 63;
  int n = cc * 64 + col;
  float acc[9];
#pragma unroll
  for (int r = 0; r < 9; ++r) acc[r] = 0.f;
  const float* w = p.in[4] + (size_t)i * 1024 * 6144 + n;
  for (int k = kq * 256; k < kq * 256 + 256; ++k) {
    float wv = w[(size_t)k * 6144];
#pragma unroll
    for (int r = 0; r < 9; ++r) acc[r] += sc[r * 1024 + k] * wv;
  }
#pragma unroll
  for (int r = 0; r < 9; ++r) red[(kq * 9 + r) * 64 + col] = acc[r];
  __syncthreads();
  for (int e = tid; e < 9 * 64; e += 256) {
    int r = e >> 6, c = e & 63;
    float s = red[(0 * 9 + r) * 64 + c] + red[(1 * 9 + r) * 64 + c] + red[(2 * 9 + r) * 64 + c] + red[(3 * 9 + r) * 64 + c];
    int nn = cc * 64 + c;
    p.mod[(size_t)(i * 9 + r) * 6144 + nn] = s + p.in[5][i * 6144 + nn];
  }
  __syncthreads();
}

__device__ __forceinline__ void prep_copy(const Params& p, int item) {
  int tid = tidx();
#pragma unroll 4
  for (int i = 0; i < 16; ++i) {
    int row = item * 16 + i;
    int b = row / PB, pp = row - b * PB;
    const float* src = (pp < CTX) ? (p.in[2] + ((size_t)b * CTX + pp) * D_) : (p.in[0] + ((size_t)b * SEQ + (pp - CTX)) * D_);
    float4 v = *(const float4*)(src + tid * 4);
    *(float4*)(p.X + (size_t)row * D_ + tid * 4) = v;
  }
}

__device__ __forceinline__ void prep_small(const Params& p, int item) {
  int tid = tidx();
  if (item == 0) {
    for (int e = tid; e < 512; e += 256) {
      int pos = e >> 3, j = e & 7;
      float inv = powf(10000.f, -(float)j / 8.f);
      float ang = (float)pos * inv;
      p.cs[e * 2] = cosf(ang); p.cs[e * 2 + 1] = sinf(ang);
    }
    for (int c = tid; c < 1024; c += 256) {
      float x0 = p.in[25][c], x1 = p.in[25][1024 + c], x2 = p.in[25][2048 + c], x3 = p.in[25][3072 + c];
      float m = fmaxf(fmaxf(x0, x1), fmaxf(x2, x3));
      float e0 = expf(x0 - m), e1 = expf(x1 - m), e2 = expf(x2 - m), e3 = expf(x3 - m);
      p.lb2[c] = (e1 + e2) / (e0 + e1 + e2 + e3);
    }
  } else {
    int idx = (item - 1) * 256 + tid;
    int dg = idx >> 6;
    float lre = p.in[15][idx], lim = p.in[16][idx];
    float dt = expf(p.in[17][dg]);
    float ar = lre * dt, ai = lim * dt;
    float er = expf(ar);
    float lbr = er * cosf(ai), lbi = er * sinf(ai);
    p.lamb[idx * 2] = lbr; p.lamb[idx * 2 + 1] = lbi;
    float nr = lbr - 1.f, ni = lbi;
    float den = lre * lre + lim * lim;
    float qr = (nr * lre + ni * lim) / den, qi = (ni * lre - nr * lim) / den;
    for (int c = 0; c < 16; ++c) {
      float br = p.in[18][idx * 16 + c], bi = p.in[19][idx * 16 + c];
      p.bbar[(idx * 16 + c) * 2] = qr * br - qi * bi;
      p.bbar[(idx * 16 + c) * 2 + 1] = qr * bi + qi * br;
    }
  }
}

__device__ __forceinline__ void modnorm_phase(const Params& p, int layer, int set, const float* gsrc) {
  int lane = tidx() & 63, wv = tidx() >> 6;
  const float* g = gsrc + layer * 1024;
  for (int row = bidx() * 4 + wv; row < T_; row += gridDim.x * 4) {
    const float* x = p.X + (size_t)row * D_;
    float4 v[4]; float ss = 0.f;
#pragma unroll
    for (int i = 0; i < 4; ++i) { v[i] = *(const float4*)(x + i * 256 + lane * 4); ss += v[i].x * v[i].x + v[i].y * v[i].y + v[i].z * v[i].z + v[i].w * v[i].w; }
    ss = wave_sum(ss);
    float rstd = rsqrtf(ss * (1.f / 1024.f) + EPS);
    const float* md = p.mod + (size_t)(layer * 9 + brow_of(row)) * 6144;
    const float* sh = md + (3 * set) * 1024; const float* sc = md + (3 * set + 1) * 1024;
#pragma unroll
    for (int i = 0; i < 4; ++i) {
      int c = i * 256 + lane * 4;
      float4 gg = *(const float4*)(g + c), s1 = *(const float4*)(sc + c), s0 = *(const float4*)(sh + c);
      bf16x4 o;
      o[0] = (short)f2bf(v[i].x * rstd * gg.x * (1.f + s1.x) + s0.x);
      o[1] = (short)f2bf(v[i].y * rstd * gg.y * (1.f + s1.y) + s0.y);
      o[2] = (short)f2bf(v[i].z * rstd * gg.z * (1.f + s1.z) + s0.z);
      o[3] = (short)f2bf(v[i].w * rstd * gg.w * (1.f + s1.w) + s0.w);
      *(bf16x4*)(p.U + (size_t)row * D_ + c) = o;
    }
  }
}

__device__ __forceinline__ void final_norm_phase(const Params& p) {
  int lane = tidx() & 63, wv = tidx() >> 6;
  const float* g = p.in[35];
  for (int r = bidx() * 4 + wv; r < NB * SEQ; r += gridDim.x * 4) {
    int b = r / SEQ, t = r - b * SEQ;
    const float* x = p.X + ((size_t)b * PB + CTX + t) * D_;
    float4 v[4]; float ss = 0.f;
#pragma unroll
    for (int i = 0; i < 4; ++i) { v[i] = *(const float4*)(x + i * 256 + lane * 4); ss += v[i].x * v[i].x + v[i].y * v[i].y + v[i].z * v[i].z + v[i].w * v[i].w; }
    ss = wave_sum(ss);
    float rstd = rsqrtf(ss * (1.f / 1024.f) + EPS);
#pragma unroll
    for (int i = 0; i < 4; ++i) {
      int c = i * 256 + lane * 4;
      float4 gg = *(const float4*)(g + c);
      float4 o = make_float4(v[i].x * rstd * gg.x, v[i].y * rstd * gg.y, v[i].z * rstd * gg.z, v[i].w * rstd * gg.w);
      *(float4*)(p.out + (size_t)r * D_ + c) = o;
    }
  }
}

struct GA {
  const u16* A; const u16* Bt; int lda, K; int row0, arb, mt, nt; int mode; int layer, set;
  void* o0; void* o1; int ldo, orb;
};
enum { E_LAT = 0, E_BF16 = 1, E_KV = 2, E_RES = 3, E_F32 = 4, E_GLU = 5, E_HG = 6 };

constexpr int GLD = 72;

__device__ __forceinline__ void gemm_tile(const Params& p, const GA& g, int tile, u16* smem) {
  const int tid = tidx(), lane = tid & 63, wv = tid >> 6;
  const int wm = wv >> 1, wn = wv & 1;
  const int l15 = lane & 15, lg = lane >> 4;
  const int tm = tile / g.nt, tn = tile - tm * g.nt;
  const int m0 = g.row0 + tm * 128, n0 = tn * 128;
  u16* sA = smem;
  u16* sB = smem + 2 * 128 * GLD;
  const u16* Ag = g.A + (size_t)(m0 - g.arb) * g.lda;
  const u16* Bg = g.Bt + (size_t)n0 * g.K;
  f32x4 acc[4][4];
#pragma unroll
  for (int i = 0; i < 4; ++i)
#pragma unroll
    for (int j = 0; j < 4; ++j) acc[i][j] = (f32x4){0.f, 0.f, 0.f, 0.f};
  bf16x8 ra[4], rb[4];
  const int nk = g.K >> 6;
  auto gload = [&](int kt) {
#pragma unroll
    for (int i = 0; i < 4; ++i) {
      int id = tid + 256 * i; int r = id >> 3, c = id & 7;
      ra[i] = *(const bf16x8*)(Ag + (size_t)r * g.lda + kt * 64 + c * 8);
      rb[i] = *(const bf16x8*)(Bg + (size_t)r * g.K + kt * 64 + c * 8);
    }
  };
  auto lstore = [&](int buf) {
#pragma unroll
    for (int i = 0; i < 4; ++i) {
      int id = tid + 256 * i; int r = id >> 3, c = id & 7;
      *(bf16x8*)(sA + (buf * 128 + r) * GLD + c * 8) = ra[i];
      *(bf16x8*)(sB + (buf * 128 + r) * GLD + c * 8) = rb[i];
    }
  };
  gload(0); lstore(0);
  __syncthreads();
  for (int kt = 0; kt < nk; ++kt) {
    const int buf = kt & 1;
    if (kt + 1 < nk) gload(kt + 1);
#pragma unroll
    for (int ks = 0; ks < 2; ++ks) {
      bf16x8 af[4], bfr[4];
#pragma unroll
      for (int i = 0; i < 4; ++i) af[i] = *(const bf16x8*)(sA + (buf * 128 + wm * 64 + 16 * i + l15) * GLD + ks * 32 + lg * 8);
#pragma unroll
      for (int j = 0; j < 4; ++j) bfr[j] = *(const bf16x8*)(sB + (buf * 128 + wn * 64 + 16 * j + l15) * GLD + ks * 32 + lg * 8);
#pragma unroll
      for (int i = 0; i < 4; ++i)
#pragma unroll
        for (int j = 0; j < 4; ++j)
          acc[i][j] = __builtin_amdgcn_mfma_f32_16x16x32_bf16(bfr[j], af[i], acc[i][j], 0, 0, 0);
    }
    if (kt + 1 < nk) lstore(buf ^ 1);
    __syncthreads();
  }
#pragma unroll
  for (int i = 0; i < 4; ++i) {
    const int row = m0 + wm * 64 + 16 * i + l15;
    if (g.mode == E_GLU) {
      const int br = brow_of(row);
      const float* gate = p.mod + (size_t)(g.layer * 9 + br) * 6144 + (3 * g.set + 2) * 1024;
#pragma unroll
      for (int j = 0; j < 2; ++j) {
        int f = tn * 64 + 32 * wn + 16 * j + 4 * lg;
        f32x4 a = acc[i][j], gg = acc[i][j + 2];
        float4 gt = *(const float4*)(gate + f);
        float* xp = p.X + (size_t)row * D_ + f;
        float4 xv = *(float4*)xp;
        xv.x += gt.x * a[0] * sigmoidf_(gg[0]); xv.y += gt.y * a[1] * sigmoidf_(gg[1]);
        xv.z += gt.z * a[2] * sigmoidf_(gg[2]); xv.w += gt.w * a[3] * sigmoidf_(gg[3]);
        *(float4*)xp = xv;
      }
      continue;
    }
#pragma unroll
    for (int j = 0; j < 4; ++j) {
      const int col = n0 + wn * 64 + 16 * j + 4 * lg;
      f32x4 v = acc[i][j];
      switch (g.mode) {
        case E_LAT: {
          if (col < 672) *(float4*)((float*)g.o0 + (size_t)row * 672 + col) = make_float4(v[0], v[1], v[2], v[3]);
        } break;
        case E_F32: {
          *(float4*)((float*)g.o0 + (size_t)(row - g.orb) * g.ldo + col) = make_float4(v[0], v[1], v[2], v[3]);
        } break;
        case E_BF16: {
          bf16x4 o; o[0] = (short)f2bf(v[0]); o[1] = (short)f2bf(v[1]); o[2] = (short)f2bf(v[2]); o[3] = (short)f2bf(v[3]);
          *(bf16x4*)((u16*)g.o0 + (size_t)(row - g.orb) * g.ldo + col) = o;
        } break;
        case E_KV: {
          int head = col >> 7, w = col & 127;
          bf16x4 o; o[0] = (short)f2bf(v[0]); o[1] = (short)f2bf(v[1]); o[2] = (short)f2bf(v[2]); o[3] = (short)f2bf(v[3]);
          u16* dst = (w < 64) ? ((u16*)g.o0 + (size_t)row * 1024 + head * 64 + w) : ((u16*)g.o1 + (size_t)row * 1024 + head * 64 + (w - 64));
          *(bf16x4*)dst = o;
        } break;
        case E_RES: {
          const int br = brow_of(row);
          const float* gate = p.mod + (size_t)(g.layer * 9 + br) * 6144 + (3 * g.set + 2) * 1024 + col;
          float4 gt = *(const float4*)gate;
          float* xp = p.X + (size_t)row * D_ + col;
          float4 xv = *(float4*)xp;
          xv.x += gt.x * v[0]; xv.y += gt.y * v[1]; xv.z += gt.z * v[2]; xv.w += gt.w * v[3];
          *(float4*)xp = xv;
        } break;
        case E_HG: {
          int part = col >> 10, c = col & 1023;
          size_t rl = (size_t)(row - g.orb);
          if (part == 0) {
            bf16x4 o;
#pragma unroll
            for (int e = 0; e < 4; ++e) o[e] = (short)f2bf(siluf_(v[e]) * 0.08838834764831845f);
            *(bf16x4*)(p.hq + rl * 1024 + c) = o;
          } else if (part <= 2) {
            float4 lb = *(const float4*)(p.lb2 + c);
            float lbv[4] = {lb.x, lb.y, lb.z, lb.w};
            __half hv[4];
#pragma unroll
            for (int e = 0; e < 4; ++e) { float f = lbv[e] + (1.f - lbv[e]) * sigmoidf_(v[e]); hv[e] = __float2half(logf(f)); }
            bf16x4 o;
#pragma unroll
            for (int e = 0; e < 4; ++e) o[e] = (short)__half_as_ushort(hv[e]);
            *(bf16x4*)(p.hlf + (size_t)(part - 1) * HR * 1024 + rl * 1024 + c) = o;
          } else if (part == 3) {
            bf16x4 o;
#pragma unroll
            for (int e = 0; e < 4; ++e) o[e] = (short)f2bf(v[e]);
            *(bf16x4*)(p.hv + rl * 1024 + c) = o;
          } else {
            bf16x4 o;
#pragma unroll
            for (int e = 0; e < 4; ++e) o[e] = (short)f2bf(siluf_(v[e]));
            *(bf16x4*)(p.hsg + rl * 1024 + c) = o;
          }
        } break;
        default: break;
      }
    }
  }
}

__device__ __forceinline__ void gemm_phase(const Params& p, const GA& g, u16* smem) {
  int ntiles = g.mt * g.nt;
  for (int t = bidx(); t < ntiles; t += gridDim.x) gemm_tile(p, g, t, smem);
}

__device__ __forceinline__ void latnorm_phase(const Params& p) {
  int lane = tidx() & 63, wv = tidx() >> 6;
  const float* gq = p.in[9]; const float* gkv = p.in[11];
  for (int row = bidx() * 4 + wv; row < T_; row += gridDim.x * 4) {
    const float* l = p.lat + (size_t)row * 672;
    float q[6]; float ss = 0.f;
#pragma unroll
    for (int i = 0; i < 6; ++i) { q[i] = l[i * 64 + lane]; ss += q[i] * q[i]; }
    ss = wave_sum(ss);
    float rq = rsqrtf(ss * (1.f / 384.f) + EPS);
#pragma unroll
    for (int i = 0; i < 6; ++i) p.qn[(size_t)row * 384 + i * 64 + lane] = f2bf(q[i] * rq * gq[i * 64 + lane]);
    float k[4]; ss = 0.f;
#pragma unroll
    for (int i = 0; i < 4; ++i) { k[i] = l[384 + i * 64 + lane]; ss += k[i] * k[i]; }
    ss = wave_sum(ss);
    float rk = rsqrtf(ss * (1.f / 256.f) + EPS);
#pragma unroll
    for (int i = 0; i < 4; ++i) p.kvn[(size_t)row * 256 + i * 64 + lane] = f2bf(k[i] * rk * gkv[i * 64 + lane]);
    int b = row / PB, pp = row - b * PB;
    float v = (lane < 32) ? l[640 + lane] : 0.f;
    int jj = lane & 15;
    float vp = __shfl_xor(v, 8);
    float o = v;
    if (pp >= CTX) {
      int t = pp - CTX;
      int sec = (lane >> 4) & 1;
      int pos = sec == 0 ? (t >> 6) : (t & 63);
      int j = jj & 7;
      float c = p.cs[(pos * 8 + j) * 2], s = p.cs[(pos * 8 + j) * 2 + 1];
      o = (jj < 8) ? (v * c - vp * s) : (vp * s + v * c);
    }
    if (lane < 32) p.kr[(size_t)row * 32 + lane] = f2bf(o);
  }
}

template <int DK, int U, int MODE>
__device__ __forceinline__ void attn_item(const Params& p, int item, u16* smem) {
  constexpr int KLD = DK + 8, VLD = 72, KS = DK / 32;
  const int tid = tidx(), lane = tid & 63, wv = tid >> 6;
  const int l15 = lane & 15, lg = lane >> 4;
  u16* sK = smem;
  u16* sV = smem + 2 * 64 * KLD;
  int b, h, qrow0, nt, r = 0, r0 = 0;
  if (MODE == 0) { int qb = item & 31; h = (item >> 5) & 15; b = item >> 9; qrow0 = b * PB + CTX + qb * 128 + wv * 32; nt = 68; }
  else if (MODE == 1) { int qb = item & 1; h = (item >> 1) & 15; b = item >> 5; qrow0 = b * PB + qb * 128 + wv * 32; nt = 4; }
  else if (MODE == 2) { r = item & 63; h = (item >> 6) & 15; b = item >> 10; qrow0 = b * PB + CTX + r * 64 + wv * 16; nt = 12; r0 = min(max(r - 4, 0), 56); }
  else { int qb = item & 3; h = (item >> 2) & 15; b = item >> 6; qrow0 = b * PB + qb * 64 + wv * 16; nt = 4; }
  const float cscale = (MODE <= 1 ? 0.10206207261596577f : 0.125f) * LOG2E;

  bf16x8 qf[U][KS];
#pragma unroll
  for (int u = 0; u < U; ++u) {
    int qrow = qrow0 + 16 * u + l15;
    const u16* qp = (MODE <= 1) ? (p.Qm + (size_t)qrow * 1536 + h * 96) : (p.QKV + (size_t)qrow * 3072 + h * 64);
#pragma unroll
    for (int ks = 0; ks < KS; ++ks) qf[u][ks] = *(const bf16x8*)(qp + ks * 32 + lg * 8);
    if (MODE == 0) {
      int t = qrow - b * PB - CTX;
      int sec = lg >> 1;
      int pos = sec == 0 ? (t >> 6) : (t & 63);
      bf16x8 o;
#pragma unroll
      for (int j = 0; j < 8; ++j) {
        float v = bf2f((u16)qf[u][2][j]);
        float vp = __shfl_xor(v, 16);
        float c = p.cs[(pos * 8 + j) * 2], s = p.cs[(pos * 8 + j) * 2 + 1];
        float ov = ((lg & 1) == 0) ? (v * c - vp * s) : (vp * s + v * c);
        o[j] = (short)f2bf(ov);
      }
      qf[u][2] = o;
    }
  }
  float mrun[U], lsum[U];
  f32x4 oacc[4][U];
#pragma unroll
  for (int u = 0; u < U; ++u) {
    mrun[u] = -1e30f; lsum[u] = 0.f;
#pragma unroll
    for (int d = 0; d < 4; ++d) oacc[d][u] = (f32x4){0.f, 0.f, 0.f, 0.f};
  }
  bf16x8 rk[2], rkr, rv[2];
  auto krow_of = [&](int kt) -> int {
    if (MODE == 0) return b * PB + kt * 64;
    if (MODE == 2) return kt < 8 ? (b * PB + CTX + (r0 + kt) * 64) : (b * PB + (kt - 8) * 64);
    return b * PB + kt * 64;
  };
  auto gload = [&](int kt) {
    int kr0 = krow_of(kt);
#pragma unroll
    for (int i = 0; i < 2; ++i) {
      int id = tid + 256 * i; int key = id >> 3, c = id & 7;
      if (MODE <= 1) {
        rk[i] = *(const bf16x8*)(p.Kn + (size_t)(kr0 + key) * 1024 + h * 64 + c * 8);
        rv[i] = *(const bf16x8*)(p.Vm + (size_t)(kr0 + key) * 1024 + h * 64 + c * 8);
      } else {
        rk[i] = *(const bf16x8*)(p.QKV + (size_t)(kr0 + key) * 3072 + 1024 + h * 64 + c * 8);
        rv[i] = *(const bf16x8*)(p.QKV + (size_t)(kr0 + key) * 3072 + 2048 + h * 64 + c * 8);
      }
    }
    if (MODE <= 1) { int key = tid >> 2, c = tid & 3; rkr = *(const bf16x8*)(p.kr + (size_t)(kr0 + key) * 32 + c * 8); }
  };
  auto lstore = [&](int buf) {
#pragma unroll
    for (int i = 0; i < 2; ++i) {
      int id = tid + 256 * i; int key = id >> 3, c = id & 7;
      *(bf16x8*)(sK + (buf * 64 + key) * KLD + c * 8) = rk[i];
#pragma unroll
      for (int e = 0; e < 8; ++e) sV[(buf * 64 + c * 8 + e) * VLD + key] = (u16)rv[i][e];
    }
    if (MODE <= 1) { int key = tid >> 2, c = tid & 3; *(bf16x8*)(sK + (buf * 64 + key) * KLD + 64 + c * 8) = rkr; }
  };
  gload(0); lstore(0);
  __syncthreads();
  for (int kt = 0; kt < nt; ++kt) {
    const int buf = kt & 1;
    if (kt + 1 < nt) gload(kt + 1);
    f32x4 sacc[4][U];
#pragma unroll
    for (int ms = 0; ms < 4; ++ms)
#pragma unroll
      for (int u = 0; u < U; ++u) sacc[ms][u] = (f32x4){0.f, 0.f, 0.f, 0.f};
#pragma unroll
    for (int ms = 0; ms < 4; ++ms) {
#pragma unroll
      for (int ks = 0; ks < KS; ++ks) {
        bf16x8 a = *(const bf16x8*)(sK + (buf * 64 + 16 * ms + l15) * KLD + ks * 32 + lg * 8);
#pragma unroll
        for (int u = 0; u < U; ++u) sacc[ms][u] = __builtin_amdgcn_mfma_f32_16x16x32_bf16(a, qf[u][ks], sacc[ms][u], 0, 0, 0);
      }
    }
    bf16x8 pf[U][2];
#pragma unroll
    for (int u = 0; u < U; ++u) {
      float tmax = -1e30f;
#pragma unroll
      for (int ms = 0; ms < 4; ++ms)
#pragma unroll
        for (int rr = 0; rr < 4; ++rr) {
          float tv = sacc[ms][u][rr] * cscale;
          if (MODE == 2 && kt < 8) {
            int w = wv * 16 + l15;
            int cc = 16 * ms + 4 * lg + rr;
            int cs0 = min(max(w - 8, 0), 48);
            int ro = (r0 + kt) - r + 7, co = cc - w + 15;
            bool ok = (cc >= cs0) && (cc < cs0 + 16);
            float bias = ok ? p.in[29][(h * 15 + ro) * 31 + co] : 0.f;
            tv = ok ? (tv + bias * LOG2E) : -1e30f;
          }
          sacc[ms][u][rr] = tv;
          tmax = fmaxf(tmax, tv);
        }
      tmax = fmaxf(tmax, __shfl_xor(tmax, 16));
      tmax = fmaxf(tmax, __shfl_xor(tmax, 32));
      float mnew = fmaxf(mrun[u], tmax);
      float alpha = exp2f(mrun[u] - mnew);
      mrun[u] = mnew;
      float ps = 0.f;
#pragma unroll
      for (int ms = 0; ms < 4; ++ms)
#pragma unroll
        for (int rr = 0; rr < 4; ++rr) {
          float pv = exp2f(sacc[ms][u][rr] - mnew);
          ps += pv;
          pf[u][ms >> 1][(ms & 1) * 4 + rr] = (short)f2bf(pv);
        }
      lsum[u] = lsum[u] * alpha + ps;
#pragma unroll
      for (int d = 0; d < 4; ++d) { oacc[d][u][0] *= alpha; oacc[d][u][1] *= alpha; oacc[d][u][2] *= alpha; oacc[d][u][3] *= alpha; }
    }
#pragma unroll
    for (int d = 0; d < 4; ++d) {
#pragma unroll
      for (int kb = 0; kb < 2; ++kb) {
        const u16* vp = sV + (buf * 64 + 16 * d + l15) * VLD + 32 * kb + 4 * lg;
        bf16x4 a0 = *(const bf16x4*)vp, a1 = *(const bf16x4*)(vp + 16);
        bf16x8 a;
        a[0] = a0[0]; a[1] = a0[1]; a[2] = a0[2]; a[3] = a0[3]; a[4] = a1[0]; a[5] = a1[1]; a[6] = a1[2]; a[7] = a1[3];
#pragma unroll
        for (int u = 0; u < U; ++u) oacc[d][u] = __builtin_amdgcn_mfma_f32_16x16x32_bf16(a, pf[u][kb], oacc[d][u], 0, 0, 0);
      }
    }
    if (kt + 1 < nt) lstore(buf ^ 1);
    __syncthreads();
  }
#pragma unroll
  for (int u = 0; u < U; ++u) {
    float l = lsum[u];
    l += __shfl_xor(l, 16); l += __shfl_xor(l, 32);
    float inv = 1.f / l;
    int qrow = qrow0 + 16 * u + l15;
#pragma unroll
    for (int d = 0; d < 4; ++d) {
      bf16x4 o;
#pragma unroll
      for (int e = 0; e < 4; ++e) o[e] = (short)f2bf(oacc[d][u][e] * inv);
      *(bf16x4*)(p.U + (size_t)qrow * D_ + h * 64 + 16 * d + 4 * lg) = o;
    }
  }
}

template <bool EMIT>
__device__ __forceinline__ void s5_scan_item(const Params& p, int item, float* smem) {
  const int tid = tidx(), lane = tid & 63, wv = tid >> 6;
  float* hs = smem + wv * 4640;
  float* Cs = hs + 2080;
  float* zs = Cs + 2304;
  int wi = item * 4 + wv;
  int c = wi % 68; int g = (wi / 68) & 31; int d = (wi / (68 * 32)) & 1; int b = wi / (68 * 64);
  int dg = d * 32 + g;
  int n = lane;
  float lr = p.lamb[(dg * 64 + n) * 2], li = p.lamb[(dg * 64 + n) * 2 + 1];
  float bbr[16], bbi[16];
#pragma unroll
  for (int cc = 0; cc < 16; ++cc) { bbr[cc] = p.bbar[((dg * 64 + n) * 16 + cc) * 2]; bbi[cc] = p.bbar[((dg * 64 + n) * 16 + cc) * 2 + 1]; }
  float hr = 0.f, hi = 0.f;
  if (EMIT) {
    hr = p.chst[((size_t)wi * 64 + n) * 2]; hi = p.chst[((size_t)wi * 64 + n) * 2 + 1];
    for (int cc = 0; cc < 16; ++cc) {
      Cs[n * 36 + cc * 2] = p.in[20][(dg * 16 + cc) * 64 + n];
      Cs[n * 36 + cc * 2 + 1] = p.in[21][(dg * 16 + cc) * 64 + n];
    }
  }
  for (int sc = 0; sc < 4; ++sc) {
    {
      int st = lane >> 2, q4 = lane & 3;
      int row = b * PB + pos_of(d, c * 64 + sc * 16 + st);
      float4 zv = *(const float4*)(p.z + (size_t)row * 512 + g * 16 + q4 * 4);
      *(float4*)(zs + st * 16 + q4 * 4) = zv;
    }
    __syncthreads();
#pragma unroll 4
    for (int st = 0; st < 16; ++st) {
      float4 z0 = *(const float4*)(zs + st * 16), z1 = *(const float4*)(zs + st * 16 + 4);
      float4 z2 = *(const float4*)(zs + st * 16 + 8), z3 = *(const float4*)(zs + st * 16 + 12);
      float zz[16] = {z0.x, z0.y, z0.z, z0.w, z1.x, z1.y, z1.z, z1.w, z2.x, z2.y, z2.z, z2.w, z3.x, z3.y, z3.z, z3.w};
      float bur = 0.f, bui = 0.f;
#pragma unroll
      for (int cc = 0; cc < 16; ++cc) { bur += bbr[cc] * zz[cc]; bui += bbi[cc] * zz[cc]; }
      float nr = lr * hr - li * hi + bur;
      float ni = lr * hi + li * hr + bui;
      hr = nr; hi = ni;
      if (EMIT) { hs[st * 130 + 2 * n] = hr; hs[st * 130 + 2 * n + 1] = hi; }
    }
    __syncthreads();
    if (EMIT) {
      int st = lane & 15, cq = lane >> 4;
      float y0 = 0.f, y1 = 0.f, y2 = 0.f, y3 = 0.f;
#pragma unroll 8
      for (int nn = 0; nn < 64; ++nn) {
        float2 hv = *(const float2*)(hs + st * 130 + 2 * nn);
        float4 c0 = *(const float4*)(Cs + nn * 36 + cq * 8), c1 = *(const float4*)(Cs + nn * 36 + cq * 8 + 4);
        y0 += c0.x * hv.x - c0.y * hv.y; y1 += c0.z * hv.x - c0.w * hv.y;
        y2 += c1.x * hv.x - c1.y * hv.y; y3 += c1.z * hv.x - c1.w * hv.y;
      }
      int row = b * PB + pos_of(d, c * 64 + sc * 16 + st);
      *(float4*)(p.yd + ((size_t)d * T_ + row) * 512 + g * 16 + cq * 4) = make_float4(y0, y1, y2, y3);
      __syncthreads();
    }
  }
  if (!EMIT) { p.chst[((size_t)wi * 64 + n) * 2] = hr; p.chst[((size_t)wi * 64 + n) * 2 + 1] = hi; }
}

__device__ __forceinline__ void s5_combine_item(const Params& p, int item) {
  const int lane = tidx() & 63, wv = tidx() >> 6;
  int wi = item * 4 + wv;
  int g = wi & 31, d = (wi >> 5) & 1;
  int dg = d * 32 + g;
  float lr = p.lamb[(dg * 64 + lane) * 2], li = p.lamb[(dg * 64 + lane) * 2 + 1];
#pragma unroll
  for (int i = 0; i < 6; ++i) { float nr = lr * lr - li * li, ni = 2.f * lr * li; lr = nr; li = ni; }
  float Hr = 0.f, Hi = 0.f;
  for (int c = 0; c < 68; ++c) {
    size_t idx = (((size_t)wi * 68 + c) * 64 + lane) * 2;
    float a = p.chst[idx], bq = p.chst[idx + 1];
    p.chst[idx] = Hr; p.chst[idx + 1] = Hi;
    float nr = lr * Hr - li * Hi + a, ni = lr * Hi + li * Hr + bq;
    Hr = nr; Hi = ni;
  }
}

__device__ __forceinline__ void s5_gelu_phase(const Params& p) {
  const float* dsk = p.in[22];
  size_t total = (size_t)T_ * 512 / 4;
  for (size_t e = (size_t)bidx() * 256 + tidx(); e < total; e += (size_t)gridDim.x * 256) {
    size_t idx = e * 4; int c = (int)(idx & 511);
    float4 zv = *(const float4*)(p.z + idx), y0 = *(const float4*)(p.yd + idx), y1 = *(const float4*)(p.yd + (size_t)T_ * 512 + idx);
    float4 dv = *(const float4*)(dsk + c);
    bf16x4 o;
    o[0] = (short)f2bf(geluf_(zv.x * dv.x + y0.x + y1.x)); o[1] = (short)f2bf(geluf_(zv.y * dv.y + y0.y + y1.y));
    o[2] = (short)f2bf(geluf_(zv.z * dv.z + y0.z + y1.z)); o[3] = (short)f2bf(geluf_(zv.w * dv.w + y0.w + y1.w));
    *(bf16x4*)(p.U + idx) = o;
  }
}

__device__ __forceinline__ void hg_scan_item(const Params& p, int item, int half, u16* smem) {
  constexpr int QLD = 136, TLD = 72;
  const int tid = tidx(), lane = tid & 63, wv = tid >> 6;
  const int l15 = lane & 15, lg = lane >> 4;
  u16* sQ = smem;
  u16* sK = sQ + 64 * QLD;
  u16* sKT = sK + 64 * QLD;
  u16* sVt = sKT + 128 * TLD;
  u16* sST = sVt + 32 * TLD;
  float* sEb = (float*)(sST + 32 * QLD);
  int vs = item & 3, d = (item >> 2) & 1, h = (item >> 3) & 7, bl = item >> 6;
  const size_t rbase = (size_t)bl * PB;
  const u16* lfp = p.hlf + (size_t)d * HR * 1024;
  u16* op = p.ho + (size_t)d * HR * 1024;
  f32x4 Sacc[2][2];
#pragma unroll
  for (int a = 0; a < 2; ++a)
#pragma unroll
    for (int c = 0; c < 2; ++c) Sacc[a][c] = (f32x4){0.f, 0.f, 0.f, 0.f};
  for (int e = tid; e < 32 * QLD; e += 256) sST[e] = 0;
  __syncthreads();
  for (int ch = 0; ch < 68; ++ch) {
#pragma unroll
    for (int i = 0; i < 4; ++i) {
      int id = tid + 256 * i; int s = id >> 4, c = id & 15;
      size_t row = rbase + pos_of(d, ch * 64 + s);
      *(bf16x8*)(sQ + s * QLD + c * 8) = *(const bf16x8*)(p.hq + row * 1024 + h * 128 + c * 8);
    }
    {
      int s = tid >> 2, c = tid & 3;
      size_t row = rbase + pos_of(d, ch * 64 + s);
      bf16x8 vv = *(const bf16x8*)(p.hv + row * 1024 + h * 128 + vs * 32 + c * 8);
#pragma unroll
      for (int e = 0; e < 8; ++e) sVt[(c * 8 + e) * TLD + s] = (u16)vv[e];
    }
    __syncthreads();
    if (tid < 128) {
      const int j = tid;
      float bsum = 0.f;
      for (int s0 = 0; s0 < 64; s0 += 8) {
        float lf[8];
#pragma unroll
        for (int e = 0; e < 8; ++e) {
          size_t row = rbase + pos_of(d, ch * 64 + s0 + e);
          lf[e] = __half2float(__ushort_as_half(lfp[row * 1024 + h * 128 + j]));
        }
        bf16x8 kt8;
#pragma unroll
        for (int e = 0; e < 8; ++e) {
          bsum += lf[e];
          float eb = __expf(bsum);
          float kk = -expm1f(lf[e]);
          float kin = kk / eb;
          float qv = bf2f(sQ[(s0 + e) * QLD + j]);
          sQ[(s0 + e) * QLD + j] = f2bf(qv * eb);
          u16 kb = f2bf(kin);
          sK[(s0 + e) * QLD + j] = kb;
          kt8[e] = (short)kb;
        }
        *(bf16x8*)(sKT + j * TLD + s0) = kt8;
      }
      sEb[j] = __expf(bsum);
    }
    __syncthreads();
    bf16x8 qfr[4];
#pragma unroll
    for (int ks = 0; ks < 4; ++ks) qfr[ks] = *(const bf16x8*)(sQ + (16 * wv + l15) * QLD + ks * 32 + lg * 8);
    f32x4 att[4];
#pragma unroll
    for (int ms = 0; ms < 4; ++ms) {
      att[ms] = (f32x4){0.f, 0.f, 0.f, 0.f};
#pragma unroll
      for (int ks = 0; ks < 4; ++ks) {
        bf16x8 a = *(const bf16x8*)(sK + (16 * ms + l15) * QLD + ks * 32 + lg * 8);
        att[ms] = __builtin_amdgcn_mfma_f32_16x16x32_bf16(a, qfr[ks], att[ms], 0, 0, 0);
      }
    }
    bf16x8 pfr[2];
    {
      int t = 16 * wv + l15;
#pragma unroll
      for (int ms = 0; ms < 4; ++ms)
#pragma unroll
        for (int rr = 0; rr < 4; ++rr) {
          int s = 16 * ms + 4 * lg + rr;
          float v = (s <= t) ? att[ms][rr] : 0.f;
          pfr[ms >> 1][(ms & 1) * 4 + rr] = (short)f2bf(v);
        }
    }
    f32x4 oacc[2];
#pragma unroll
    for (int nv = 0; nv < 2; ++nv) {
      oacc[nv] = (f32x4){0.f, 0.f, 0.f, 0.f};
#pragma unroll
      for (int kb = 0; kb < 2; ++kb) {
        const u16* vp = sVt + (16 * nv + l15) * TLD + 32 * kb + 4 * lg;
        bf16x4 a0 = *(const bf16x4*)vp, a1 = *(const bf16x4*)(vp + 16);
        bf16x8 a;
        a[0] = a0[0]; a[1] = a0[1]; a[2] = a0[2]; a[3] = a0[3]; a[4] = a1[0]; a[5] = a1[1]; a[6] = a1[2]; a[7] = a1[3];
        oacc[nv] = __builtin_amdgcn_mfma_f32_16x16x32_bf16(a, pfr[kb], oacc[nv], 0, 0, 0);
      }
#pragma unroll
      for (int ks = 0; ks < 4; ++ks) {
        bf16x8 a = *(const bf16x8*)(sST + (16 * nv + l15) * QLD + ks * 32 + lg * 8);
        oacc[nv] = __builtin_amdgcn_mfma_f32_16x16x32_bf16(a, qfr[ks], oacc[nv], 0, 0, 0);
      }
    }
    {
      int t = 16 * wv + l15;
      size_t row = rbase + pos_of(d, ch * 64 + t);
#pragma unroll
      for (int nv = 0; nv < 2; ++nv) {
        bf16x4 o;
#pragma unroll
        for (int e = 0; e < 4; ++e) o[e] = (short)f2bf(oacc[nv][e]);
        *(bf16x4*)(op + row * 1024 + h * 128 + vs * 32 + 16 * nv + 4 * lg) = o;
      }
    }
#pragma unroll
    for (int md = 0; md < 2; ++md)
#pragma unroll
      for (int kb = 0; kb < 2; ++kb) {
        bf16x8 a = *(const bf16x8*)(sKT + (32 * wv + 16 * md + l15) * TLD + kb * 32 + lg * 8);
#pragma unroll
        for (int nv = 0; nv < 2; ++nv) {
          bf16x8 bb = *(const bf16x8*)(sVt + (16 * nv + l15) * TLD + kb * 32 + lg * 8);
          Sacc[md][nv] = __builtin_amdgcn_mfma_f32_16x16x32_bf16(a, bb, Sacc[md][nv], 0, 0, 0);
        }
      }
    __syncthreads();
#pragma unroll
    for (int md = 0; md < 2; ++md) {
      int d0 = 32 * wv + 16 * md + 4 * lg;
      float4 eb = *(const float4*)(sEb + d0);
#pragma unroll
      for (int nv = 0; nv < 2; ++nv) {
        Sacc[md][nv][0] *= eb.x; Sacc[md][nv][1] *= eb.y; Sacc[md][nv][2] *= eb.z; Sacc[md][nv][3] *= eb.w;
        bf16x4 o;
#pragma unroll
        for (int e = 0; e < 4; ++e) o[e] = (short)f2bf(Sacc[md][nv][e]);
        *(bf16x4*)(sST + (16 * nv + l15) * QLD + d0) = o;
      }
    }
    __syncthreads();
  }
}

__device__ __forceinline__ void hg_readout_phase(const Params& p, int half) {
  int lane = tidx() & 63, wv = tidx() >> 6;
  const float* ng = p.in[26];
  for (int rl = bidx() * 4 + wv; rl < HR; rl += gridDim.x * 4) {
    size_t o = (size_t)rl * 1024 + lane * 16;
    bf16x8 a0 = *(const bf16x8*)(p.ho + o), a1 = *(const bf16x8*)(p.ho + o + 8);
    bf16x8 b0 = *(const bf16x8*)(p.ho + (size_t)HR * 1024 + o), b1 = *(const bf16x8*)(p.ho + (size_t)HR * 1024 + o + 8);
    bf16x8 g0 = *(const bf16x8*)(p.hsg + o), g1 = *(const bf16x8*)(p.hsg + o + 8);
    float v[16]; float ss = 0.f;
#pragma unroll
    for (int e = 0; e < 8; ++e) {
      v[e] = bf2f((u16)a0[e]) + bf2f((u16)b0[e]);
      v[8 + e] = bf2f((u16)a1[e]) + bf2f((u16)b1[e]);
    }
#pragma unroll
    for (int e = 0; e < 16; ++e) ss += v[e] * v[e];
    ss += __shfl_xor(ss, 1); ss += __shfl_xor(ss, 2); ss += __shfl_xor(ss, 4);
    float rstd = rsqrtf(ss * (1.f / 128.f) + EPS);
    bf16x8 o0, o1;
#pragma unroll
    for (int e = 0; e < 8; ++e) {
      o0[e] = (short)f2bf(v[e] * rstd * ng[lane * 16 + e] * bf2f((u16)g0[e]));
      o1[e] = (short)f2bf(v[8 + e] * rstd * ng[lane * 16 + 8 + e] * bf2f((u16)g1[e]));
    }
    size_t uo = ((size_t)half * HR + rl) * 1024 + lane * 16;
    *(bf16x8*)(p.U + uo) = o0; *(bf16x8*)(p.U + uo + 8) = o1;
  }
}

__device__ __forceinline__ void convgate_phase(const Params& p, int layer) {
  const float* cw = p.in[32] + (size_t)layer * 3 * F2;
  const float* cb = p.in[33] + (size_t)layer * F2;
  const size_t total = (size_t)HR * (F_ / 8);
  for (size_t e = (size_t)bidx() * 256 + tidx(); e < total; e += (size_t)gridDim.x * 256) {
    int rl = (int)(e / (F_ / 8)); int f = (int)(e % (F_ / 8)) * 8;
    int pp = rl % PB;
    bool hasp = (pp != 0) && (pp != CTX);
    bool hasn = (pp != CTX - 1) && (pp != PB - 1);
    const u16* hrow = p.H + (size_t)rl * F2;
    float a[8], gq[8];
#pragma unroll
    for (int part = 0; part < 2; ++part) {
      int fo = f + part * F_;
      bf16x8 c1 = *(const bf16x8*)(hrow + fo);
      bf16x8 c0 = c1, c2 = c1;
      if (hasp) c0 = *(const bf16x8*)(hrow - F2 + fo);
      if (hasn) c2 = *(const bf16x8*)(hrow + F2 + fo);
      float* dst = part == 0 ? a : gq;
#pragma unroll
      for (int k = 0; k < 8; ++k) {
        float v = bf2f((u16)c1[k]) * cw[F2 + fo + k] + cb[fo + k];
        if (hasp) v += bf2f((u16)c0[k]) * cw[fo + k];
        if (hasn) v += bf2f((u16)c2[k]) * cw[2 * F2 + fo + k];
        dst[k] = v;
      }
    }
    bf16x8 o;
#pragma unroll
    for (int k = 0; k < 8; ++k) o[k] = (short)f2bf(a[k] * siluf_(gq[k]));
    *(bf16x8*)(p.act + (size_t)rl * F_ + f) = o;
  }
}

constexpr int SMEM_BYTES = 74240;
enum { T_PREP = 0, T_NORM, T_GEMM, T_LATNORM, T_ATTN_MLA, T_S5A, T_S5B, T_S5C, T_S5GELU, T_HGSCAN, T_HGRO, T_ATTN_NA, T_CONVGATE, T_FINAL, T_NONE };
struct PD { int type, layer, set, half; GA g, g2; };

__device__ __forceinline__ void get_phase(const Params& p, int target, PD& pd) {
  int ph = 0;
  pd.type = T_NONE; pd.layer = 0; pd.set = 0; pd.half = 0;
  pd.g = GA{}; pd.g2 = GA{};
#define AT(code) { if (ph == target) { code } ++ph; }
  AT(pd.type = T_PREP;)
  for (int layer = 0; layer < 4; ++layer) {
    AT(pd.type = T_NORM; pd.layer = layer; pd.set = 0;)
    if (layer == 0) {
      AT(pd.type = T_GEMM; GA& g = pd.g; g.A = p.U; g.lda = 1024; g.Bt = p.w_mla_in; g.K = 1024; g.mt = T_ / 128; g.nt = 6; g.mode = E_LAT; g.o0 = p.lat;)
      AT(pd.type = T_LATNORM;)
      AT(pd.type = T_GEMM; GA& g = pd.g; g.A = p.qn; g.lda = 384; g.Bt = p.w_mla_q; g.K = 384; g.mt = T_ / 128; g.nt = 12; g.mode = E_BF16; g.o0 = p.Qm; g.ldo = 1536;
         GA& g2 = pd.g2; g2.A = p.kvn; g2.lda = 256; g2.Bt = p.w_mla_kv; g2.K = 256; g2.mt = T_ / 128; g2.nt = 16; g2.mode = E_KV; g2.o0 = p.Kn; g2.o1 = p.Vm;)
      AT(pd.type = T_ATTN_MLA;)
      AT(pd.type = T_GEMM; GA& g = pd.g; g.A = p.U; g.lda = 1024; g.Bt = p.w_mla_out; g.K = 1024; g.mt = T_ / 128; g.nt = 8; g.mode = E_RES; g.layer = 0; g.set = 0;)
    } else if (layer == 1) {
      AT(pd.type = T_GEMM; GA& g = pd.g; g.A = p.U; g.lda = 1024; g.Bt = p.w_s5_in; g.K = 1024; g.mt = T_ / 128; g.nt = 4; g.mode = E_F32; g.o0 = p.z; g.ldo = 512;)
      AT(pd.type = T_S5A;)
      AT(pd.type = T_S5B;)
      AT(pd.type = T_S5C;)
      AT(pd.type = T_S5GELU;)
      AT(pd.type = T_GEMM; GA& g = pd.g; g.A = p.U; g.lda = 512; g.Bt = p.w_s5_glu; g.K = 512; g.mt = T_ / 128; g.nt = 16; g.mode = E_GLU; g.layer = 1; g.set = 0;)
    } else if (layer == 2) {
      for (int half = 0; half < 2; ++half) {
        AT(pd.type = T_GEMM; GA& g = pd.g; g.A = p.U; g.lda = 1024; g.Bt = p.w_hg_in; g.K = 1024; g.row0 = half * HR; g.mt = HR / 128; g.nt = 40; g.mode = E_HG; g.orb = half * HR;)
        AT(pd.type = T_HGSCAN; pd.half = half;)
        AT(pd.type = T_HGRO; pd.half = half;)
      }
      AT(pd.type = T_GEMM; GA& g = pd.g; g.A = p.U; g.lda = 1024; g.Bt = p.w_hg_out; g.K = 1024; g.mt = T_ / 128; g.nt = 8; g.mode = E_RES; g.layer = 2; g.set = 0;)
    } else {
      AT(pd.type = T_GEMM; GA& g = pd.g; g.A = p.U; g.lda = 1024; g.Bt = p.w_na_qkv; g.K = 1024; g.mt = T_ / 128; g.nt = 24; g.mode = E_BF16; g.o0 = p.QKV; g.ldo = 3072;)
      AT(pd.type = T_ATTN_NA;)
      AT(pd.type = T_GEMM; GA& g = pd.g; g.A = p.U; g.lda = 1024; g.Bt = p.w_na_out; g.K = 1024; g.mt = T_ / 128; g.nt = 8; g.mode = E_RES; g.layer = 3; g.set = 0;)
    }
    AT(pd.type = T_NORM; pd.layer = layer; pd.set = 1;)
    for (int half = 0; half < 2; ++half) {
      AT(pd.type = T_GEMM; GA& g = pd.g; g.A = p.U; g.lda = 1024; g.Bt = p.w_up[layer]; g.K = 1024; g.row0 = half * HR; g.mt = HR / 128; g.nt = 44; g.mode = E_BF16; g.o0 = p.H; g.ldo = F2; g.orb = half * HR;)
      AT(pd.type = T_CONVGATE; pd.layer = layer;)
      AT(pd.type = T_GEMM; GA& g = pd.g; g.A = p.act; g.lda = F_; g.Bt = p.w_down[layer]; g.K = F_; g.row0 = half * HR; g.arb = half * HR; g.mt = HR / 128; g.nt = 8; g.mode = E_RES; g.layer = layer; g.set = 1;)
    }
  }
  AT(pd.type = T_FINAL;)
#undef AT
}

__global__ void __launch_bounds__(256, 2) mega(Params p, int ph_lo, int ph_hi) {
  cg::grid_group grid = cg::this_grid();
  __shared__ __attribute__((aligned(16))) unsigned char smem_raw[SMEM_BYTES];
  u16* smem = (u16*)smem_raw;
  float* smf = (float*)smem_raw;
  const int G = gridDim.x, bid = bidx();
  for (int ph = ph_lo; ph < ph_hi; ++ph) {
    if (ph > ph_lo) grid.sync();
    PD pd;
    get_phase(p, ph, pd);
    switch (pd.type) {
      case T_PREP: {
        int n0 = p.ntt, n1 = n0 + 384, n2 = n1 + T_ / 16, n3 = n2 + 17;
        for (int it = bid; it < n3; it += G) {
          if (it < n0) prep_transpose(p, it, smf);
          else if (it < n1) prep_mod(p, it - n0, smf);
          else if (it < n2) prep_copy(p, it - n1);
          else prep_small(p, it - n2);
        }
      } break;
      case T_NORM: modnorm_phase(p, pd.layer, pd.set, pd.set == 0 ? p.in[6] : p.in[7]); break;
      case T_GEMM: {
        int t1 = pd.g.mt * pd.g.nt, t2 = pd.g2.mt * pd.g2.nt;
        for (int t = bid; t < t1 + t2; t += G) {
          bool first = t < t1;
          GA cur = first ? pd.g : pd.g2;
          gemm_tile(p, cur, first ? t : t - t1, smem);
        }
      } break;
      case T_LATNORM: latnorm_phase(p); break;
      case T_ATTN_MLA: {
        for (int it = bid; it < 4096 + 256; it += G) {
          if (it < 4096) attn_item<96, 2, 0>(p, it, smem); else attn_item<96, 2, 1>(p, it - 4096, smem);
        }
      } break;
      case T_S5A: for (int it = bid; it < 8704; it += G) s5_scan_item<false>(p, it, smf); break;
      case T_S5B: for (int it = bid; it < 128; it += G) s5_combine_item(p, it); break;
      case T_S5C: for (int it = bid; it < 8704; it += G) s5_scan_item<true>(p, it, smf); break;
      case T_S5GELU: s5_gelu_phase(p); break;
      case T_HGSCAN: for (int it = bid; it < 256; it += G) hg_scan_item(p, it, pd.half, smem); break;
      case T_HGRO: hg_readout_phase(p, pd.half); break;
      case T_ATTN_NA: for (int it = bid; it < 8192; it += G) attn_item<64, 1, 2>(p, it, smem); break;
      case T_CONVGATE: convgate_phase(p, pd.layer); break;
      case T_FINAL: final_norm_phase(p); break;
      default: break;
    }
  }
}

constexpr int N_PHASES = 55;

extern "C" void kernel_launch(void* const* d_in, const int* in_sizes, int n_in, void* d_out, int out_size,
                              void* d_ws, size_t ws_size, hipStream_t stream) {
  Params p;
  memset(&p, 0, sizeof(p));
  for (int i = 0; i < 36; ++i) p.in[i] = (const float*)d_in[i];
  p.out = (float*)d_out;
  char* ws = (char*)d_ws;
  size_t off = 0;
  auto take = [&](size_t bytes) { char* r = ws + off; off += (bytes + 255) & ~(size_t)255; return r; };
  p.X = (float*)take((size_t)T_ * D_ * 4);
  p.U = (u16*)take((size_t)T_ * D_ * 2);
  p.mod = (float*)take((size_t)4 * 9 * 6144 * 4);
  p.cs = (float*)take(4096);
  p.lb2 = (float*)take(4096);
  p.lamb = (float*)take(2 * 32 * 64 * 2 * 4);
  p.bbar = (float*)take(2 * 32 * 64 * 16 * 2 * 4);
  int ntd = 0, ntt = 0;
  auto addw = [&](const float* src, int K, int N, int Npad, int mode) -> u16* {
    u16* dst = (u16*)take((size_t)Npad * K * 2);
    p.td[ntd].src = src; p.td[ntd].dst = dst; p.td[ntd].K = K; p.td[ntd].N = N; p.td[ntd].Npad = Npad; p.td[ntd].mode = mode;
    ntt += (K / 64) * (Npad / 64); ++ntd;
    return dst;
  };
  p.w_mla_in = addw(p.in[8], 1024, 672, 768, 0);
  p.w_mla_q = addw(p.in[10], 384, 1536, 1536, 0);
  p.w_mla_kv = addw(p.in[12], 256, 2048, 2048, 0);
  p.w_mla_out = addw(p.in[13], 1024, 1024, 1024, 0);
  p.w_s5_in = addw(p.in[14], 1024, 512, 512, 0);
  p.w_s5_glu = addw(p.in[23], 512, 2048, 2048, 1);
  p.w_hg_in = addw(p.in[24], 1024, 5120, 5120, 0);
  p.w_hg_out = addw(p.in[27], 1024, 1024, 1024, 0);
  p.w_na_qkv = addw(p.in[28], 1024, 3072, 3072, 0);
  p.w_na_out = addw(p.in[30], 1024, 1024, 1024, 0);
  for (int i = 0; i < 4; ++i) {
    p.w_up[i] = addw(p.in[31] + (size_t)i * 1024 * F2, 1024, F2, F2, 0);
    p.w_down[i] = addw(p.in[34] + (size_t)i * F_ * 1024, F_, 1024, 1024, 0);
  }
  p.ntd = ntd; p.ntt = ntt;
  char* S = ws + off;
  char* O2 = (char*)d_out;
  p.lat = (float*)S; p.Qm = (u16*)S; p.Kn = (u16*)(S + (size_t)T_ * 1536 * 2);
  p.Vm = (u16*)O2; p.qn = (u16*)(O2 + (size_t)T_ * 1024 * 2); p.kvn = p.qn + (size_t)T_ * 384; p.kr = p.kvn + (size_t)T_ * 256;
  p.z = (float*)S; p.yd = (float*)(S + (size_t)T_ * 512 * 4); p.chst = (float*)O2;
  p.hq = (u16*)S; p.hlf = p.hq + (size_t)HR * 1024; p.hv = p.hlf + (size_t)2 * HR * 1024; p.hsg = p.hv + (size_t)HR * 1024; p.ho = (u16*)O2;
  p.QKV = (u16*)S;
  p.H = (u16*)S; p.act = (u16*)O2;

  static int grid_blocks = 0;
  if (!grid_blocks) {
    int dev = 0, cus = 0, per_cu = 0;
    (void)hipGetDevice(&dev);
    (void)hipDeviceGetAttribute(&cus, hipDeviceAttributeMultiprocessorCount, dev);
    (void)hipOccupancyMaxActiveBlocksPerMultiprocessor(&per_cu, mega, 256, 0);
    if (per_cu < 1) per_cu = 1;
    if (per_cu > 2) per_cu = 2;
    grid_blocks = cus * per_cu;
  }
#if ONE_LAUNCH
  int lo = 0, hi = N_PHASES;
  void* args[] = {&p, &lo, &hi};
  hipError_t e = hipLaunchCooperativeKernel((void*)mega, dim3(grid_blocks), dim3(256), args, 0, stream);
  if (e != hipSuccess) fprintf(stderr, "cooperative launch failed: %s (grid %d)\n", hipGetErrorString(e), grid_blocks);
#else
  for (int ph = 0; ph < N_PHASES; ++ph) {
    hipLaunchKernelGGL(mega, dim3(grid_blocks), dim3(256), 0, stream, p, ph, ph + 1);
  }
#endif
}
```

```cpp
#include <hip/hip_runtime.h>
#include <hip/hip_bf16.h>
#include <hip/hip_fp16.h>
#include <hip/hip_cooperative_groups.h>
#include <cstdio>
#include <cstring>
namespace cg = cooperative_groups;

#ifndef ONE_LAUNCH
#define ONE_LAUNCH 1
#endif

typedef __attribute__((ext_vector_type(8))) short bf16x8;
typedef __attribute__((ext_vector_type(4))) short bf16x4;
typedef __attribute__((ext_vector_type(4))) float f32x4;
typedef unsigned short u16;

constexpr int NB = 8, SEQ = 4096, CTX = 256, PB = 4352, T_ = 34816, D_ = 1024;
constexpr int F_ = 2816, F2 = 5632;
constexpr int HR = 17408;
constexpr float EPS = 1e-6f;
constexpr float LOG2E = 1.4426950408889634f;

struct TDesc { const float* src; u16* dst; int K, N, Npad, mode; };

struct Params {
  const float* in[36];
  float* out;
  unsigned* bar; float* part0; float* part3;
  float* X; u16* U; float* mod; float* cs; float* lb2; float* lamb; float* bbar;
  u16* w_mla_in; u16* w_mla_q; u16* w_mla_kv; u16* w_mla_out;
  u16* w_s5_in; u16* w_s5_glu; u16* w_hg_in; u16* w_hg_out; u16* w_na_qkv; u16* w_na_out;
  u16* w_up[4]; u16* w_down[4];
  float* lat; u16* Qm; u16* Kn; u16* Vm; u16* qn; u16* kvn; u16* kr;
  float* z; float* yd; float* chst;
  u16* hq; u16* hlf; u16* hv; u16* hsg; u16* ho;
  u16* QKV;
  u16* H; u16* act;
  TDesc td[20];
  int ntd; int ntt;
};

__device__ __forceinline__ int tidx() { int t = threadIdx.x; asm volatile("" : "+v"(t)); return t; }
__device__ __forceinline__ int vtid() { return tidx() & 255; }
__device__ __forceinline__ int bidx() { int t = blockIdx.x; asm volatile("" : "+s"(t)); return t; }
__device__ __forceinline__ u16 f2bf(float f) {
  unsigned u = __float_as_uint(f);
  u += 0x7fffu + ((u >> 16) & 1u);
  return (u16)(u >> 16);
}
typedef __attribute__((ext_vector_type(4))) unsigned u32x4;
typedef __attribute__((ext_vector_type(2))) float f32x2_t;
typedef __attribute__((ext_vector_type(2))) __bf16 bf16x2_t;
__device__ __forceinline__ unsigned pack_bf16(float a, float b) {
  f32x2_t v = {a, b};
  bf16x2_t r = __builtin_convertvector(v, bf16x2_t);
  return __builtin_bit_cast(unsigned, r);
}
__device__ __forceinline__ float vmax(float a, float b) { return __builtin_fmaxf(a, b); }
__device__ __forceinline__ float vmax3(float a, float b, float c) { return __builtin_fmaxf(__builtin_fmaxf(a, b), c); }
__device__ __forceinline__ float bf2f(u16 h) { return __uint_as_float(((unsigned)h) << 16); }
__device__ __forceinline__ float sigmoidf_(float x) { return 1.f / (1.f + __expf(-x)); }
__device__ __forceinline__ float siluf_(float x) { return x / (1.f + __expf(-x)); }
__device__ __forceinline__ float geluf_(float x) {
  float u = 0.7978845608028654f * (x + 0.044715f * x * x * x);
  return 0.5f * x * (1.f + tanhf(u));
}
__device__ __forceinline__ float wave_sum(float v) {
#pragma unroll
  for (int o = 32; o > 0; o >>= 1) v += __shfl_xor(v, o);
  return v;
}
__device__ __forceinline__ int brow_of(int row) {
  int b = row / PB; int pp = row - b * PB;
  return pp < CTX ? 8 : b;
}
__device__ __forceinline__ int pos_of(int d, int s) {
  return d == 0 ? s : (s < CTX ? (CTX - 1 - s) : (PB + CTX - 1 - s));
}

__device__ __forceinline__ const float* in_row(const Params& p, int row) {
  int b = row / PB, pp = row - b * PB;
  return (pp < CTX) ? (p.in[2] + ((size_t)b * CTX + pp) * D_) : (p.in[0] + ((size_t)b * SEQ + (pp - CTX)) * D_);
}
__device__ __forceinline__ int glu_map(int np, int halfn) {
  int tile = np >> 8, c = np & 255;
  int wn = c >> 6, s = (c & 63) >> 4;
  int f = tile * 128 + 32 * wn + 16 * (s & 1) + (c & 15);
  return f + ((s >= 2) ? halfn : 0);
}

__device__ __forceinline__ void prep_transpose(const Params& p, int item, float* ts) {
  int di = 0, rem = item;
  for (; di < p.ntd; ++di) {
    int nt = (p.td[di].K >> 6) * (p.td[di].Npad >> 6);
    if (rem < nt) break;
    rem -= nt;
  }
  const TDesc& t = p.td[di];
  int ntn = t.Npad >> 6;
  int kk0 = (rem / ntn) * 64, n0 = (rem % ntn) * 64;
  int tid = vtid();
#pragma unroll
  for (int i = 0; i < 4; ++i) {
    int kl = (tid >> 4) + 16 * i;
    int nl = (tid & 15) * 4;
    int np = n0 + nl;
    int sc = (t.mode == 1) ? glu_map(np, 1024) : ((t.mode == 2) ? glu_map(np, F_) : np);
    float4 v = make_float4(0.f, 0.f, 0.f, 0.f);
    if (np < t.N) { f32x4 t4 = __builtin_nontemporal_load((const f32x4*)(t.src + (size_t)(kk0 + kl) * t.N + sc)); v = make_float4(t4[0], t4[1], t4[2], t4[3]); }
    ts[(nl + 0) * 65 + kl] = v.x; ts[(nl + 1) * 65 + kl] = v.y;
    ts[(nl + 2) * 65 + kl] = v.z; ts[(nl + 3) * 65 + kl] = v.w;
  }
  __syncthreads();
  {
    int nl = tid >> 2, kq = (tid & 3) * 16;
    bf16x8 o0, o1;
#pragma unroll
    for (int e = 0; e < 8; ++e) { o0[e] = (short)f2bf(ts[nl * 65 + kq + e]); o1[e] = (short)f2bf(ts[nl * 65 + kq + 8 + e]); }
    u16* d = t.dst + (size_t)(n0 + nl) * t.K + kk0 + kq;
    *(bf16x8*)d = o0; *(bf16x8*)(d + 8) = o1;
  }
  __syncthreads();
}

__device__ __forceinline__ void prep_mod(const Params& p, int item, float* sm) {
  int i = item / 96, cc = item % 96;
  float* sc = sm;
  float* red = sm + 9 * 1024;
  int tid = vtid();
  for (int e = tid; e < 9 * 1024; e += 256) {
    int r = e >> 10, k = e & 1023;
    float v = (r < 8) ? p.in[1][r * 1024 + k] : p.in[3][k];
    sc[e] = siluf_(v);
  }
  __syncthreads();
  int kq = tid >> 6, col = tid & 63;
  int n = cc * 64 + col;
  float acc[9];
#pragma unroll
  for (int r = 0; r < 9; ++r) acc[r] = 0.f;
  const float* w = p.in[4] + (size_t)i * 1024 * 6144 + n;
  for (int k = kq * 256; k < kq * 256 + 256; ++k) {
    float wv = __builtin_nontemporal_load(w + (size_t)k * 6144);
#pragma unroll
    for (int r = 0; r < 9; ++r) acc[r] += sc[r * 1024 + k] * wv;
  }
#pragma unroll
  for (int r = 0; r < 9; ++r) red[(kq * 9 + r) * 64 + col] = acc[r];
  __syncthreads();
  for (int e = tid; e < 9 * 64; e += 256) {
    int r = e >> 6, c = e & 63;
    float s = red[(0 * 9 + r) * 64 + c] + red[(1 * 9 + r) * 64 + c] + red[(2 * 9 + r) * 64 + c] + red[(3 * 9 + r) * 64 + c];
    int nn = cc * 64 + c;
    p.mod[(size_t)(i * 9 + r) * 6144 + nn] = s + p.in[5][i * 6144 + nn];
  }
  __syncthreads();
}

__device__ __forceinline__ void prep_copy(const Params& p, int item) {
  int tid = vtid();
#pragma unroll 4
  for (int i = 0; i < 16; ++i) {
    int row = item * 16 + i;
    int b = row / PB, pp = row - b * PB;
    const float* src = (pp < CTX) ? (p.in[2] + ((size_t)b * CTX + pp) * D_) : (p.in[0] + ((size_t)b * SEQ + (pp - CTX)) * D_);
    float4 v = *(const float4*)(src + tid * 4);
    *(float4*)(p.X + (size_t)row * D_ + tid * 4) = v;
  }
}

__device__ __forceinline__ void prep_small(const Params& p, int item) {
  int tid = vtid();
  if (item == 0) {
    for (int e = tid; e < 512; e += 256) {
      int pos = e >> 3, j = e & 7;
      float inv = powf(10000.f, -(float)j / 8.f);
      float ang = (float)pos * inv;
      p.cs[e * 2] = cosf(ang); p.cs[e * 2 + 1] = sinf(ang);
    }
    for (int c = tid; c < 1024; c += 256) {
      float x0 = p.in[25][c], x1 = p.in[25][1024 + c], x2 = p.in[25][2048 + c], x3 = p.in[25][3072 + c];
      float m = fmaxf(fmaxf(x0, x1), fmaxf(x2, x3));
      float e0 = expf(x0 - m), e1 = expf(x1 - m), e2 = expf(x2 - m), e3 = expf(x3 - m);
      p.lb2[c] = (e1 + e2) / (e0 + e1 + e2 + e3);
    }
  } else {
    int idx = (item - 1) * 256 + tid;
    int dg = idx >> 6;
    float lre = p.in[15][idx], lim = p.in[16][idx];
    float dt = expf(p.in[17][dg]);
    float ar = lre * dt, ai = lim * dt;
    float er = expf(ar);
    float lbr = er * cosf(ai), lbi = er * sinf(ai);
    p.lamb[idx * 2] = lbr; p.lamb[idx * 2 + 1] = lbi;
    float nr = lbr - 1.f, ni = lbi;
    float den = lre * lre + lim * lim;
    float qr = (nr * lre + ni * lim) / den, qi = (ni * lre - nr * lim) / den;
    for (int c = 0; c < 16; ++c) {
      float br = p.in[18][idx * 16 + c], bi = p.in[19][idx * 16 + c];
      p.bbar[(idx * 16 + c) * 2] = qr * br - qi * bi;
      p.bbar[(idx * 16 + c) * 2 + 1] = qr * bi + qi * br;
    }
  }
}

__device__ __forceinline__ void modnorm_phase(const Params& p, int layer, int set, const float* gsrc, int fixl) {
  int lane = tidx() & 63, wv = tidx() >> 6;
  const float* g = gsrc + layer * 1024;
  for (int row0 = (bidx() * 8 + wv) * 4; row0 < T_; row0 += gridDim.x * 32) {
    float4 v[4][4]; float ss[4];
#pragma unroll
    for (int rr = 0; rr < 4; ++rr) {
      const float* x = (layer == 0 && set == 0) ? in_row(p, row0 + rr) : (p.X + (size_t)(row0 + rr) * D_);
#pragma unroll
      for (int i = 0; i < 4; ++i) v[rr][i] = *(const float4*)(x + i * 256 + lane * 4);
    }
    if (fixl >= 0 && row0 >= 32768) {
      const float* gate = p.mod + (size_t)(fixl * 9 + brow_of(row0)) * 6144 + 5 * 1024;
#pragma unroll
      for (int i = 0; i < 4; ++i) {
        int c = i * 256 + lane * 4;
        float4 gt = *(const float4*)(gate + c);
#pragma unroll
        for (int rr = 0; rr < 4; ++rr) {
          float4 a = make_float4(0.f, 0.f, 0.f, 0.f);
#pragma unroll
          for (int q = 0; q < 8; ++q) {
            float4 t = *(const float4*)(p.part0 + ((size_t)q * 2048 + (row0 + rr - 32768)) * 1024 + c);
            a.x += t.x; a.y += t.y; a.z += t.z; a.w += t.w;
          }
          v[rr][i].x += gt.x * a.x; v[rr][i].y += gt.y * a.y; v[rr][i].z += gt.z * a.z; v[rr][i].w += gt.w * a.w;
          *(float4*)(p.X + (size_t)(row0 + rr) * D_ + c) = v[rr][i];
        }
      }
    }
#pragma unroll
    for (int rr = 0; rr < 4; ++rr) {
      float s = 0.f;
#pragma unroll
      for (int i = 0; i < 4; ++i) s += v[rr][i].x * v[rr][i].x + v[rr][i].y * v[rr][i].y + v[rr][i].z * v[rr][i].z + v[rr][i].w * v[rr][i].w;
      ss[rr] = rsqrtf(wave_sum(s) * (1.f / 1024.f) + EPS);
    }
    const float* md = p.mod + (size_t)(layer * 9 + brow_of(row0)) * 6144;
    const float* sh = md + (3 * set) * 1024; const float* sc = md + (3 * set + 1) * 1024;
#pragma unroll
    for (int i = 0; i < 4; ++i) {
      int c = i * 256 + lane * 4;
      float4 gg = *(const float4*)(g + c), s1 = *(const float4*)(sc + c), s0 = *(const float4*)(sh + c);
      gg.x *= (1.f + s1.x); gg.y *= (1.f + s1.y); gg.z *= (1.f + s1.z); gg.w *= (1.f + s1.w);
#pragma unroll
      for (int rr = 0; rr < 4; ++rr) {
        float rstd = ss[rr];
        bf16x4 o;
        o[0] = (short)f2bf(v[rr][i].x * rstd * gg.x + s0.x);
        o[1] = (short)f2bf(v[rr][i].y * rstd * gg.y + s0.y);
        o[2] = (short)f2bf(v[rr][i].z * rstd * gg.z + s0.z);
        o[3] = (short)f2bf(v[rr][i].w * rstd * gg.w + s0.w);
        *(bf16x4*)(p.U + (size_t)(row0 + rr) * D_ + c) = o;
      }
    }
  }
}

__device__ __forceinline__ void final_norm_phase(const Params& p, bool fix) {
  int lane = tidx() & 63, wv = tidx() >> 6;
  const float* g = p.in[35];
  for (int r = bidx() * 8 + wv; r < NB * SEQ; r += gridDim.x * 8) {
    int b = r / SEQ, t = r - b * SEQ;
    const int grow = b * PB + CTX + t;
    const float* x = p.X + (size_t)grow * D_;
    float4 v[4]; float ss = 0.f;
#pragma unroll
    for (int i = 0; i < 4; ++i) v[i] = *(const float4*)(x + i * 256 + lane * 4);
    if (fix && grow >= 32768) {
      const float* gate = p.mod + (size_t)(3 * 9 + b) * 6144 + 5 * 1024;
#pragma unroll
      for (int i = 0; i < 4; ++i) {
        int c = i * 256 + lane * 4;
        float4 gt = *(const float4*)(gate + c);
        float4 a = make_float4(0.f, 0.f, 0.f, 0.f);
#pragma unroll
        for (int q = 0; q < 8; ++q) {
          float4 tq = *(const float4*)(p.part3 + ((size_t)q * 2048 + (grow - 32768)) * 1024 + c);
          a.x += tq.x; a.y += tq.y; a.z += tq.z; a.w += tq.w;
        }
        v[i].x += gt.x * a.x; v[i].y += gt.y * a.y; v[i].z += gt.z * a.z; v[i].w += gt.w * a.w;
      }
    }
#pragma unroll
    for (int i = 0; i < 4; ++i) ss += v[i].x * v[i].x + v[i].y * v[i].y + v[i].z * v[i].z + v[i].w * v[i].w;
    ss = wave_sum(ss);
    float rstd = rsqrtf(ss * (1.f / 1024.f) + EPS);
#pragma unroll
    for (int i = 0; i < 4; ++i) {
      int c = i * 256 + lane * 4;
      float4 gg = *(const float4*)(g + c);
      float4 o = make_float4(v[i].x * rstd * gg.x, v[i].y * rstd * gg.y, v[i].z * rstd * gg.z, v[i].w * rstd * gg.w);
      { f32x4 o4 = {o.x, o.y, o.z, o.w}; __builtin_nontemporal_store(o4, (f32x4*)(p.out + (size_t)r * D_ + c)); }
    }
  }
}

struct GA {
  const u16* A; const u16* Bt; int lda, K; int row0, arb, mt, nt; int mode; int layer, set;
  void* o0; void* o1; int ldo, orb; float scale;
  int kb, ke;
};
enum { E_LAT = 0, E_BF16 = 1, E_KV = 2, E_RES = 3, E_F32 = 4, E_GLU = 5, E_HG = 6, E_FFNUP = 7, E_PART = 8 };

constexpr int GLD = 72;

__device__ __forceinline__ void gemm_tile(const Params& p, const GA& g, int tm, int tn, u16* smem) {
  const int tid = tidx(), lane = tid & 63, wv = tid >> 6;
  const int wm = wv >> 2, wn = wv & 3;
  const int l15 = lane & 15, lg = lane >> 4;
  int m0 = g.row0 + tm * 256; const int n0 = tn * 256;
  int frow0 = 0;
  if (g.mode == E_FFNUP) { frow0 = 254 * tm - 1; m0 = 0; }
  unsigned char* sm8 = (unsigned char*)smem;
  const u16* Ag = g.A + (size_t)(m0 - g.arb) * g.lda;
  const u16* Bg = g.Bt + (size_t)n0 * g.K;
  f32x4 acc[8][4];
#pragma unroll
  for (int i = 0; i < 8; ++i)
#pragma unroll
    for (int j = 0; j < 4; ++j) acc[i][j] = (f32x4){0.f, 0.f, 0.f, 0.f};
  const int nk = g.K >> 6;
  auto glds_piece = [&](int kt, int buf, int i) {
    int q = wv * 4 + i;
    int r = 8 * q + (lane >> 3);
    int csrc = (lane & 7) ^ ((r >> 1) & 7);
    int ar = r;
    if (g.mode == E_FFNUP) ar = min(max(frow0 + r, 0), T_ - 1);
    const u16* ga = Ag + (size_t)ar * g.lda + kt * 64 + csrc * 8;
    const u16* gb = Bg + (size_t)r * g.K + kt * 64 + csrc * 8;
    unsigned char* la = sm8 + buf * 65536 + q * 1024 + lane * 16;
    __builtin_amdgcn_global_load_lds((const unsigned*)ga, (__attribute__((address_space(3))) unsigned*)la, 16, 0, 0);
    __builtin_amdgcn_global_load_lds((const unsigned*)gb, (__attribute__((address_space(3))) unsigned*)(la + 32768), 16, 0, 0);
  };
  const int kb = g.kb, ke = (g.ke > 0) ? g.ke : nk;
#pragma unroll
  for (int i = 0; i < 4; ++i) glds_piece(kb, 0, i);
  asm volatile("s_waitcnt vmcnt(0)" ::: "memory");
  __syncthreads();
  { const int k1 = (kb + 1 < ke) ? kb + 1 : kb; glds_piece(k1, 1, 0); glds_piece(k1, 1, 1); }
  const int sw = l15 >> 1;
  bf16x8 cb[4], ca[2];
  {
    const unsigned char* pa = sm8 + (wm * 128 + l15) * 128;
    const unsigned char* pb = sm8 + 32768 + (wn * 64 + l15) * 128;
    const int co = ((0 * 4 + lg) ^ sw) << 4;
#pragma unroll
    for (int j = 0; j < 4; ++j) cb[j] = *(const bf16x8*)(pb + j * 2048 + co);
    ca[0] = *(const bf16x8*)(pa + co); ca[1] = *(const bf16x8*)(pa + 2048 + co);
  }
  for (int kt = kb; kt < ke; ++kt) {
    const int buf = (kt - kb) & 1;
    const int ktn = (kt + 1 < ke) ? kt + 1 : kt;
    const unsigned char* pa = sm8 + buf * 65536 + (wm * 128 + l15) * 128;
    const unsigned char* pb = sm8 + buf * 65536 + 32768 + (wn * 64 + l15) * 128;
    const unsigned char* pan = sm8 + (buf ^ 1) * 65536 + (wm * 128 + l15) * 128;
    const unsigned char* pbn = sm8 + (buf ^ 1) * 65536 + 32768 + (wn * 64 + l15) * 128;
#pragma unroll
    for (int s = 0; s < 8; ++s) {
      const int ks = s >> 2, pp = s & 3;
      bf16x8 nb[4], na[2];
      if (s < 2) glds_piece(ktn, buf ^ 1, s + 2);
      if (s < 7) {
        const int ks2 = (s + 1) >> 2, p2 = (s + 1) & 3;
        const int co = ((ks2 * 4 + lg) ^ sw) << 4;
        if (p2 == 0) {
#pragma unroll
          for (int j = 0; j < 4; ++j) nb[j] = *(const bf16x8*)(pb + j * 2048 + co);
        }
        na[0] = *(const bf16x8*)(pa + (2 * p2) * 2048 + co);
        na[1] = *(const bf16x8*)(pa + (2 * p2 + 1) * 2048 + co);
      } else {
        asm volatile("s_waitcnt vmcnt(0)" ::: "memory");
        __syncthreads();
        { const int k2 = (kt + 2 < ke) ? kt + 2 : ke - 1; glds_piece(k2, buf, 0); glds_piece(k2, buf, 1); }
        const int co = ((0 * 4 + lg) ^ sw) << 4;
#pragma unroll
        for (int j = 0; j < 4; ++j) nb[j] = *(const bf16x8*)(pbn + j * 2048 + co);
        na[0] = *(const bf16x8*)(pan + co);
        na[1] = *(const bf16x8*)(pan + 2048 + co);
      }
#pragma unroll
      for (int ii = 0; ii < 2; ++ii)
#pragma unroll
        for (int j = 0; j < 4; ++j)
          acc[2 * pp + ii][j] = __builtin_amdgcn_mfma_f32_16x16x32_bf16(cb[j], ca[ii], acc[2 * pp + ii][j], 0, 0, 0);
      ca[0] = na[0]; ca[1] = na[1];
      if (s == 3 || s == 7) {
#pragma unroll
        for (int j = 0; j < 4; ++j) cb[j] = nb[j];
      }
      if (s & 1) __builtin_amdgcn_sched_barrier(0);
    }
  }
  asm volatile("s_waitcnt vmcnt(0)" ::: "memory");
  __syncthreads();
  if (g.mode == E_FFNUP) {
    u16* sT = smem;
#pragma unroll
    for (int i = 0; i < 8; ++i) {
      int lr = wm * 128 + 16 * i + l15;
#pragma unroll
      for (int j = 0; j < 4; ++j) {
        int cl = ((j >= 2) ? 128 : 0) + 32 * wn + 16 * (j & 1) + 4 * lg;
        f32x4 v = acc[i][j];
        bf16x4 o; o[0] = (short)f2bf(v[0]); o[1] = (short)f2bf(v[1]); o[2] = (short)f2bf(v[2]); o[3] = (short)f2bf(v[3]);
        *(bf16x4*)(sT + lr * 264 + cl) = o;
      }
    }
    __syncthreads();
    {
      const float* cw = p.in[32] + (size_t)g.layer * 3 * F2;
      const float* cb = p.in[33] + (size_t)g.layer * F2;
      const int f4 = (tid & 31) * 4;
      const int fg = tn * 128 + f4;
      float4 wa0 = *(const float4*)(cw + fg), wa1 = *(const float4*)(cw + F2 + fg), wa2 = *(const float4*)(cw + 2 * F2 + fg);
      float4 wg0 = *(const float4*)(cw + F_ + fg), wg1 = *(const float4*)(cw + F2 + F_ + fg), wg2 = *(const float4*)(cw + 2 * F2 + F_ + fg);
      float4 ba = *(const float4*)(cb + fg), bg = *(const float4*)(cb + F_ + fg);
#pragma unroll 4
      for (int it = 0; it < 16; ++it) {
        int lr = 1 + (tid >> 5) + 16 * it;
        int row = frow0 + lr;
        if (lr <= 254 && row < T_) {
          int pp = row % PB;
          bool hasp = (pp != 0) && (pp != CTX);
          bool hasn = (pp != CTX - 1) && (pp != PB - 1);
          float mp = hasp ? 1.f : 0.f, mn = hasn ? 1.f : 0.f;
          bf16x4 a0 = *(const bf16x4*)(sT + (lr - 1) * 264 + f4), a1 = *(const bf16x4*)(sT + lr * 264 + f4), a2 = *(const bf16x4*)(sT + (lr + 1) * 264 + f4);
          bf16x4 g0 = *(const bf16x4*)(sT + (lr - 1) * 264 + 128 + f4), g1 = *(const bf16x4*)(sT + lr * 264 + 128 + f4), g2 = *(const bf16x4*)(sT + (lr + 1) * 264 + 128 + f4);
          float w0[4] = {wa0.x, wa0.y, wa0.z, wa0.w}, w1[4] = {wa1.x, wa1.y, wa1.z, wa1.w}, w2[4] = {wa2.x, wa2.y, wa2.z, wa2.w};
          float v0[4] = {wg0.x, wg0.y, wg0.z, wg0.w}, v1[4] = {wg1.x, wg1.y, wg1.z, wg1.w}, v2[4] = {wg2.x, wg2.y, wg2.z, wg2.w};
          float bb[4] = {ba.x, ba.y, ba.z, ba.w}, bgv[4] = {bg.x, bg.y, bg.z, bg.w};
          bf16x4 o;
#pragma unroll
          for (int e = 0; e < 4; ++e) {
            float av = bf2f((u16)a1[e]) * w1[e] + bb[e] + mp * bf2f((u16)a0[e]) * w0[e] + mn * bf2f((u16)a2[e]) * w2[e];
            float gv = bf2f((u16)g1[e]) * v1[e] + bgv[e] + mp * bf2f((u16)g0[e]) * v0[e] + mn * bf2f((u16)g2[e]) * v2[e];
            o[e] = (short)f2bf(av * siluf_(gv));
          }
          *(bf16x4*)(p.act + (size_t)row * F_ + fg) = o;
        }
      }
    }
    __syncthreads();
    return;
  }
#define EPI_LOOP(...) \
  _Pragma("unroll") for (int i = 0; i < 8; ++i) { \
    const int row = m0 + wm * 128 + 16 * i + l15; \
    _Pragma("unroll") for (int j = 0; j < 4; ++j) { \
      const int col = n0 + wn * 64 + 16 * j + 4 * lg; \
      f32x4 v = acc[i][j]; \
      __VA_ARGS__ \
      asm volatile("" ::: "memory"); \
    } }
  switch (g.mode) {
    case E_GLU: {
      float4 gtg[2];
      {
        const float* gate = p.mod + (size_t)(g.layer * 9 + brow_of(m0)) * 6144 + (3 * g.set + 2) * 1024;
#pragma unroll
        for (int j = 0; j < 2; ++j) {
          float4 c = *(const float4*)(gate + tn * 128 + 32 * wn + 16 * j + 4 * lg);
          gtg[j] = make_float4(c.x * g.scale, c.y * g.scale, c.z * g.scale, c.w * g.scale);
        }
      }
#pragma unroll
      for (int i4 = 0; i4 < 8; i4 += 2) {
        float4 xv[2][2];
#pragma unroll
        for (int ii = 0; ii < 2; ++ii) {
          const int row = m0 + wm * 128 + 16 * (i4 + ii) + l15;
#pragma unroll
          for (int j = 0; j < 2; ++j) xv[ii][j] = *(const float4*)(p.X + (size_t)row * D_ + tn * 128 + 32 * wn + 16 * j + 4 * lg);
        }
#pragma unroll
        for (int ii = 0; ii < 2; ++ii) {
          const int row = m0 + wm * 128 + 16 * (i4 + ii) + l15;
#pragma unroll
          for (int j = 0; j < 2; ++j) {
            f32x4 a = acc[i4 + ii][j], gg = acc[i4 + ii][j + 2];
            float4 x = xv[ii][j], gt = gtg[j];
            x.x += gt.x * a[0] * sigmoidf_(gg[0]); x.y += gt.y * a[1] * sigmoidf_(gg[1]);
            x.z += gt.z * a[2] * sigmoidf_(gg[2]); x.w += gt.w * a[3] * sigmoidf_(gg[3]);
            *(float4*)(p.X + (size_t)row * D_ + tn * 128 + 32 * wn + 16 * j + 4 * lg) = x;
          }
        }
        asm volatile("" ::: "memory");
      }
    } break;
    case E_LAT: {
      EPI_LOOP(if (col < 672) *(float4*)((float*)g.o0 + (size_t)row * 672 + col) = make_float4(v[0], v[1], v[2], v[3]);)
    } break;
    case E_PART: {
      EPI_LOOP(*(float4*)((float*)g.o0 + (size_t)(row - g.orb) * 1024 + col) = make_float4(v[0], v[1], v[2], v[3]);)
    } break;
    case E_F32: {
      EPI_LOOP(*(float4*)((float*)g.o0 + (size_t)(row - g.orb) * g.ldo + col) = make_float4(v[0], v[1], v[2], v[3]);)
    } break;
    case E_BF16: {
      EPI_LOOP(bf16x4 o; o[0] = (short)f2bf(v[0]); o[1] = (short)f2bf(v[1]); o[2] = (short)f2bf(v[2]); o[3] = (short)f2bf(v[3]);
               *(bf16x4*)((u16*)g.o0 + (size_t)(row - g.orb) * g.ldo + col) = o;)
    } break;
    case E_KV: {
      EPI_LOOP(int head = col >> 7; int w = col & 127;
               bf16x4 o; o[0] = (short)f2bf(v[0]); o[1] = (short)f2bf(v[1]); o[2] = (short)f2bf(v[2]); o[3] = (short)f2bf(v[3]);
               u16* dst = (w < 64) ? ((u16*)g.o0 + (size_t)row * 1024 + head * 64 + w) : ((u16*)g.o1 + (size_t)row * 1024 + head * 64 + (w - 64));
               *(bf16x4*)dst = o;)
    } break;
    case E_RES: {
      float4 gtr[4];
      {
        const float* gate = p.mod + (size_t)(g.layer * 9 + brow_of(m0)) * 6144 + (3 * g.set + 2) * 1024;
#pragma unroll
        for (int j = 0; j < 4; ++j) {
          float4 c = *(const float4*)(gate + n0 + wn * 64 + 16 * j + 4 * lg);
          gtr[j] = make_float4(c.x * g.scale, c.y * g.scale, c.z * g.scale, c.w * g.scale);
        }
      }
      const bool first = (g.layer == 0 && g.set == 0);
#pragma unroll
      for (int i2 = 0; i2 < 8; i2 += 2) {
        float4 xv[2][4];
#pragma unroll
        for (int ii = 0; ii < 2; ++ii) {
          const int row = m0 + wm * 128 + 16 * (i2 + ii) + l15;
          const float* xr = first ? in_row(p, row) : (p.X + (size_t)row * D_);
#pragma unroll
          for (int j = 0; j < 4; ++j) xv[ii][j] = *(const float4*)(xr + n0 + wn * 64 + 16 * j + 4 * lg);
        }
#pragma unroll
        for (int ii = 0; ii < 2; ++ii) {
          const int row = m0 + wm * 128 + 16 * (i2 + ii) + l15;
#pragma unroll
          for (int j = 0; j < 4; ++j) {
            f32x4 v = acc[i2 + ii][j];
            float4 x = xv[ii][j], gt = gtr[j];
            x.x += gt.x * v[0]; x.y += gt.y * v[1]; x.z += gt.z * v[2]; x.w += gt.w * v[3];
            *(float4*)(p.X + (size_t)row * D_ + n0 + wn * 64 + 16 * j + 4 * lg) = x;
          }
        }
        asm volatile("" ::: "memory");
      }
    } break;
    case E_HG: {
      float4 lbh[4];
#pragma unroll
      for (int j = 0; j < 4; ++j) lbh[j] = *(const float4*)(p.lb2 + ((n0 + wn * 64 + 16 * j + 4 * lg) & 1023));
      EPI_LOOP(int part = col >> 10; int c = col & 1023;
               size_t rl = (size_t)(row - g.orb);
               bf16x4 o;
               if (part == 0) {
                 _Pragma("unroll") for (int e = 0; e < 4; ++e) o[e] = (short)f2bf(siluf_(v[e]) * 0.08838834764831845f);
                 *(bf16x4*)(p.hq + rl * 1024 + c) = o;
               } else if (part <= 2) {
                 float4 lb = lbh[j];
                 float lbv[4] = {lb.x, lb.y, lb.z, lb.w};
                 _Pragma("unroll") for (int e = 0; e < 4; ++e) { float f = lbv[e] + (1.f - lbv[e]) * sigmoidf_(v[e]); o[e] = (short)__half_as_ushort(__float2half(__logf(f))); }
                 *(bf16x4*)(p.hlf + (size_t)(part - 1) * HR * 1024 + rl * 1024 + c) = o;
               } else if (part == 3) {
                 _Pragma("unroll") for (int e = 0; e < 4; ++e) o[e] = (short)f2bf(v[e]);
                 *(bf16x4*)(p.hv + rl * 1024 + c) = o;
               } else {
                 _Pragma("unroll") for (int e = 0; e < 4; ++e) o[e] = (short)f2bf(siluf_(v[e]));
                 *(bf16x4*)(p.hsg + rl * 1024 + c) = o;
               })
    } break;
    default: break;
  }
#undef EPI_LOOP
}

__device__ __forceinline__ void latnorm_phase(const Params& p) {
  int lane = tidx() & 63, wv = tidx() >> 6;
  const float* gq = p.in[9]; const float* gkv = p.in[11];
  for (int row = bidx() * 8 + wv; row < T_; row += gridDim.x * 8) {
    const float* l = p.lat + (size_t)row * 672;
    float q[6]; float ss = 0.f;
#pragma unroll
    for (int i = 0; i < 6; ++i) { q[i] = l[i * 64 + lane]; ss += q[i] * q[i]; }
    ss = wave_sum(ss);
    float rq = rsqrtf(ss * (1.f / 384.f) + EPS);
#pragma unroll
    for (int i = 0; i < 6; ++i) p.qn[(size_t)row * 384 + i * 64 + lane] = f2bf(q[i] * rq * gq[i * 64 + lane]);
    float k[4]; ss = 0.f;
#pragma unroll
    for (int i = 0; i < 4; ++i) { k[i] = l[384 + i * 64 + lane]; ss += k[i] * k[i]; }
    ss = wave_sum(ss);
    float rk = rsqrtf(ss * (1.f / 256.f) + EPS);
#pragma unroll
    for (int i = 0; i < 4; ++i) p.kvn[(size_t)row * 256 + i * 64 + lane] = f2bf(k[i] * rk * gkv[i * 64 + lane]);
    int b = row / PB, pp = row - b * PB;
    float v = (lane < 32) ? l[640 + lane] : 0.f;
    int jj = lane & 15;
    float vp = __shfl_xor(v, 8);
    float o = v;
    if (pp >= CTX) {
      int t = pp - CTX;
      int sec = (lane >> 4) & 1;
      int pos = sec == 0 ? (t >> 6) : (t & 63);
      int j = jj & 7;
      float c = p.cs[(pos * 8 + j) * 2], s = p.cs[(pos * 8 + j) * 2 + 1];
      o = (jj < 8) ? (v * c - vp * s) : (vp * s + v * c);
    }
    if (lane < 32) p.kr[(size_t)row * 32 + lane] = f2bf(o);
  }
}

template <int DK, int U, int MODE, int NW, int SUB>
__device__ __forceinline__ void attn_item(const Params& p, int item, u16* smem) {
  constexpr int NT = 64 * NW, KT = 64 * SUB;
  constexpr int KLD = DK + 8, VLD = 72, KS = DK / 32;
  const int tid = (NW == 8) ? tidx() : vtid(), lane = tid & 63, wv = tid >> 6;
  const int l15 = lane & 15, lg = lane >> 4;
  u16* sK = smem;
  u16* sV = smem + 2 * KT * KLD;
  float* sBias = (float*)(smem + 2 * KT * KLD + 2 * KT * VLD);
  int b, h, qrow0, nt, r = 0, r0 = 0, rq = 0, r0q = 0;
  constexpr int NLOC = (MODE == 2 && U == 2) ? 9 : 8;
  if (MODE == 0 && NW == 8) { int qb = item & 15; h = (item >> 4) & 15; b = item >> 8; qrow0 = b * PB + CTX + qb * 256 + wv * 32; nt = 68 / SUB; }
  else if (MODE == 1 && NW == 8) { h = item & 15; b = item >> 4; qrow0 = b * PB + wv * 32; nt = 4 / SUB; }
  else if (MODE == 0) { int qb = item & 31; h = (item >> 5) & 15; b = item >> 9; qrow0 = b * PB + CTX + qb * 128 + wv * 32; nt = 68; }
  else if (MODE == 1) { int qb = item & 1; h = (item >> 1) & 15; b = item >> 5; qrow0 = b * PB + qb * 128 + wv * 32; nt = 4; }
  else if (MODE == 2 && U == 2) {
    r = 2 * (item & 31); h = (item >> 5) & 15; b = item >> 9;
    rq = r + (wv >> 1); qrow0 = b * PB + CTX + rq * 64 + (wv & 1) * 32; nt = 13;
    r0 = min(max(r - 4, 0), 56); r0q = min(max(rq - 4, 0), 56);
  }
  else if (MODE == 2) { r = item & 63; h = (item >> 6) & 15; b = item >> 10; qrow0 = b * PB + CTX + r * 64 + wv * 16; nt = 12; r0 = min(max(r - 4, 0), 56); rq = r; r0q = r0; }
  else { int qb = item & 3; h = (item >> 2) & 15; b = item >> 6; qrow0 = b * PB + qb * 64 + wv * 16; nt = 4; }
  const float cscale = (MODE <= 1 ? 0.10206207261596577f : 0.125f) * LOG2E;

  bf16x8 qf[U][KS];
#pragma unroll
  for (int u = 0; u < U; ++u) {
    int qrow = qrow0 + 16 * u + l15;
    const u16* qp = (MODE <= 1) ? (p.Qm + (size_t)qrow * 1536 + h * 96) : (p.QKV + (size_t)qrow * 3072 + h * 64);
#pragma unroll
    for (int ks = 0; ks < KS; ++ks) qf[u][ks] = *(const bf16x8*)(qp + ks * 32 + lg * 8);
    if (MODE == 0) {
      int t = qrow - b * PB - CTX;
      int sec = lg >> 1;
      int pos = sec == 0 ? (t >> 6) : (t & 63);
      bf16x8 o;
#pragma unroll
      for (int j = 0; j < 8; ++j) {
        float v = bf2f((u16)qf[u][2][j]);
        float vp = __shfl_xor(v, 16);
        float c = p.cs[(pos * 8 + j) * 2], s = p.cs[(pos * 8 + j) * 2 + 1];
        float ov = ((lg & 1) == 0) ? (v * c - vp * s) : (vp * s + v * c);
        o[j] = (short)f2bf(ov);
      }
      qf[u][2] = o;
    }
  }
  float mrun[U], lsum[U];
  f32x4 oacc[4][U];
#pragma unroll
  for (int u = 0; u < U; ++u) {
    mrun[u] = -1e30f; lsum[u] = 0.f;
#pragma unroll
    for (int d = 0; d < 4; ++d) oacc[d][u] = (f32x4){0.f, 0.f, 0.f, 0.f};
  }
  bf16x8 rk[2], rkr, rv[2];
  auto krow_of = [&](int kt) -> int {
    if (MODE == 0) return b * PB + kt * KT;
    if (MODE == 2) return kt < NLOC ? (b * PB + CTX + min(r0 + kt, 63) * 64) : (b * PB + (kt - NLOC) * 64);
    return b * PB + kt * KT;
  };
  auto gload = [&](int kt) {
    int kr0 = krow_of(kt);
#pragma unroll
    for (int i = 0; i < 2; ++i) {
      int id = tid + NT * i; int key = id >> 3, c = id & 7;
      if (MODE <= 1) {
        rk[i] = *(const bf16x8*)(p.Kn + (size_t)(kr0 + key) * 1024 + h * 64 + c * 8);
        rv[i] = *(const bf16x8*)(p.Vm + (size_t)(kr0 + key) * 1024 + h * 64 + c * 8);
      } else {
        rk[i] = *(const bf16x8*)(p.QKV + (size_t)(kr0 + key) * 3072 + 1024 + h * 64 + c * 8);
        rv[i] = *(const bf16x8*)(p.QKV + (size_t)(kr0 + key) * 3072 + 2048 + h * 64 + c * 8);
      }
    }
    if (MODE <= 1) { int key = tid >> 2, c = tid & 3; rkr = *(const bf16x8*)(p.kr + (size_t)(kr0 + key) * 32 + c * 8); }
  };
  auto lstore = [&](int buf) {
#pragma unroll
    for (int i = 0; i < 2; ++i) {
      int id = tid + NT * i; int key = id >> 3, c = id & 7;
      *(bf16x8*)(sK + (buf * KT + key) * KLD + c * 8) = rk[i];
      *(bf16x8*)(sV + (buf * KT + key) * VLD + c * 8) = rv[i];
    }
    if (MODE <= 1) { int key = tid >> 2, c = tid & 3; *(bf16x8*)(sK + (buf * KT + key) * KLD + 64 + c * 8) = rkr; }
  };
  gload(0); lstore(0);
  if (MODE == 2) { for (int e = tid; e < 465; e += NT) sBias[e] = p.in[29][h * 465 + e] * LOG2E; }
  __syncthreads();
  for (int kt = 0; kt < nt; ++kt) {
    const int buf = kt & 1;
    if (kt + 1 < nt) gload(kt + 1);
#pragma unroll
    for (int sub = 0; sub < SUB; ++sub) {
    f32x4 sacc[4][U];
#pragma unroll
    for (int ms = 0; ms < 4; ++ms)
#pragma unroll
      for (int u = 0; u < U; ++u) sacc[ms][u] = (f32x4){0.f, 0.f, 0.f, 0.f};
    const bool local_tile = (MODE == 2) && (kt < NLOC);
    if (MODE == 2 && local_tile && (unsigned)((r0 + kt) - r0q) >= 8u) continue;
    const int mlo = (MODE == 2 && U == 1 && local_tile) ? ((wv <= 1) ? 0 : wv - 1) : 0;
    const int mhi = (MODE == 2 && U == 1 && local_tile) ? ((wv >= 2) ? 3 : wv + 1) : 3;
    if (MODE <= 1) {
#pragma unroll
      for (int hf = 0; hf < 2; ++hf) {
        bf16x8 kf[2][KS];
#pragma unroll
        for (int m2 = 0; m2 < 2; ++m2)
#pragma unroll
          for (int ks = 0; ks < KS; ++ks)
            kf[m2][ks] = *(const bf16x8*)(sK + (buf * KT + sub * 64 + 16 * (2 * hf + m2) + l15) * KLD + ks * 32 + lg * 8);
        __builtin_amdgcn_sched_barrier(0);
        __builtin_amdgcn_s_setprio(1);
#pragma unroll
        for (int m2 = 0; m2 < 2; ++m2)
#pragma unroll
          for (int ks = 0; ks < KS; ++ks)
#pragma unroll
            for (int u = 0; u < U; ++u)
              sacc[2 * hf + m2][u] = __builtin_amdgcn_mfma_f32_16x16x32_bf16(kf[m2][ks], qf[u][ks], sacc[2 * hf + m2][u], 0, 0, 0);
        __builtin_amdgcn_s_setprio(0);
        __builtin_amdgcn_sched_barrier(0);
      }
    } else {
      bf16x8 kf[4][KS];
#pragma unroll
      for (int ms = 0; ms < 4; ++ms)
#pragma unroll
        for (int ks = 0; ks < KS; ++ks)
          kf[ms][ks] = *(const bf16x8*)(sK + (buf * KT + sub * 64 + 16 * ms + l15) * KLD + ks * 32 + lg * 8);
      __builtin_amdgcn_sched_barrier(0);
#pragma unroll
      for (int ms = 0; ms < 4; ++ms) {
        if (MODE == 2 && (ms < mlo || ms > mhi)) continue;
#pragma unroll
        for (int ks = 0; ks < KS; ++ks)
#pragma unroll
          for (int u = 0; u < U; ++u) sacc[ms][u] = __builtin_amdgcn_mfma_f32_16x16x32_bf16(kf[ms][ks], qf[u][ks], sacc[ms][u], 0, 0, 0);
      }
      __builtin_amdgcn_sched_barrier(0);
    }
    bf16x8 pf[U][2];
#pragma unroll
    for (int u = 0; u < U; ++u) {
      const float* brow = nullptr; int dlt = 0;
      if (MODE == 2) {
        int w = (U == 2) ? ((wv & 1) * 32 + 16 * u + l15) : (wv * 16 + l15);
        int cs0 = min(max(w - 8, 0), 48);
        dlt = 4 * lg - cs0;
        brow = sBias + ((r0 + kt) - rq + 7) * 31 + (4 * lg - w + 15);
      }
      float tmax = -1e30f;
      if (local_tile) {
#pragma unroll
        for (int ms = 0; ms < 4; ++ms) {
          if (ms < mlo || ms > mhi) continue;
#pragma unroll
          for (int rr = 0; rr < 4; ++rr) {
            bool ok = (unsigned)(16 * ms + rr + dlt) < 16u;
            float tv = ok ? __builtin_fmaf(sacc[ms][u][rr], cscale, brow[16 * ms + rr]) : -1e30f;
            sacc[ms][u][rr] = tv;
            tmax = vmax(tmax, tv);
          }
        }
      } else {
#pragma unroll
        for (int ms = 0; ms < 4; ++ms) {
          tmax = vmax3(tmax, sacc[ms][u][0], sacc[ms][u][1]);
          tmax = vmax3(tmax, sacc[ms][u][2], sacc[ms][u][3]);
        }
        tmax *= cscale;
      }
      tmax = vmax(tmax, __shfl_xor(tmax, 16));
      tmax = vmax(tmax, __shfl_xor(tmax, 32));
      if (__any(tmax > mrun[u] + 8.f)) {
        float mnew = vmax(mrun[u], tmax);
        float alpha = __builtin_amdgcn_exp2f(mrun[u] - mnew);
        mrun[u] = mnew;
        lsum[u] *= alpha;
#pragma unroll
        for (int d = 0; d < 4; ++d) { oacc[d][u][0] *= alpha; oacc[d][u][1] *= alpha; oacc[d][u][2] *= alpha; oacc[d][u][3] *= alpha; }
      }
      const float mr = mrun[u];
      float ps = 0.f;
      u32x4 pk[2];
#pragma unroll
      for (int ms = 0; ms < 4; ++ms) {
        if (MODE == 2 && (ms < mlo || ms > mhi)) { pk[ms >> 1][(ms & 1) * 2] = 0u; pk[ms >> 1][(ms & 1) * 2 + 1] = 0u; continue; }
        float pv[4];
#pragma unroll
        for (int rr = 0; rr < 4; ++rr) {
          float x = local_tile ? (sacc[ms][u][rr] - mr) : __builtin_fmaf(sacc[ms][u][rr], cscale, -mr);
          pv[rr] = __builtin_amdgcn_exp2f(x);
          ps += pv[rr];
        }
        pk[ms >> 1][(ms & 1) * 2] = pack_bf16(pv[0], pv[1]);
        pk[ms >> 1][(ms & 1) * 2 + 1] = pack_bf16(pv[2], pv[3]);
      }
      lsum[u] += ps;
      pf[u][0] = __builtin_bit_cast(bf16x8, pk[0]);
      pf[u][1] = __builtin_bit_cast(bf16x8, pk[1]);
    }
    if (MODE <= 1) {
#pragma unroll
      for (int hf = 0; hf < 2; ++hf) {
        bf16x8 vf[2][2];
#pragma unroll
        for (int d2 = 0; d2 < 2; ++d2)
#pragma unroll
          for (int kb = 0; kb < 2; ++kb) {
            const u16* vp = sV + (buf * KT + sub * 64 + 32 * kb + 4 * lg + (l15 >> 2)) * VLD + 16 * (2 * hf + d2) + 4 * (l15 & 3);
            bf16x4 a0 = __builtin_amdgcn_ds_read_tr16_b64_v4i16((__attribute__((address_space(3))) bf16x4*)vp);
            bf16x4 a1 = __builtin_amdgcn_ds_read_tr16_b64_v4i16((__attribute__((address_space(3))) bf16x4*)(vp + 16 * VLD));
            bf16x8 a;
            a[0] = a0[0]; a[1] = a0[1]; a[2] = a0[2]; a[3] = a0[3]; a[4] = a1[0]; a[5] = a1[1]; a[6] = a1[2]; a[7] = a1[3];
            vf[d2][kb] = a;
          }
        __builtin_amdgcn_sched_barrier(0);
        __builtin_amdgcn_s_setprio(1);
#pragma unroll
        for (int d2 = 0; d2 < 2; ++d2)
#pragma unroll
          for (int kb = 0; kb < 2; ++kb)
#pragma unroll
            for (int u = 0; u < U; ++u)
              oacc[2 * hf + d2][u] = __builtin_amdgcn_mfma_f32_16x16x32_bf16(vf[d2][kb], pf[u][kb], oacc[2 * hf + d2][u], 0, 0, 0);
        __builtin_amdgcn_s_setprio(0);
        __builtin_amdgcn_sched_barrier(0);
      }
    } else {
#pragma unroll
      for (int hf = 0; hf < 2; ++hf) {
        bf16x8 vf[2][2];
#pragma unroll
        for (int d2 = 0; d2 < 2; ++d2)
#pragma unroll
          for (int kb = 0; kb < 2; ++kb) {
            const u16* vp = sV + (buf * KT + sub * 64 + 32 * kb + 4 * lg + (l15 >> 2)) * VLD + 16 * (2 * hf + d2) + 4 * (l15 & 3);
            bf16x4 a0 = __builtin_amdgcn_ds_read_tr16_b64_v4i16((__attribute__((address_space(3))) bf16x4*)vp);
            bf16x4 a1 = __builtin_amdgcn_ds_read_tr16_b64_v4i16((__attribute__((address_space(3))) bf16x4*)(vp + 16 * VLD));
            bf16x8 a;
            a[0] = a0[0]; a[1] = a0[1]; a[2] = a0[2]; a[3] = a0[3]; a[4] = a1[0]; a[5] = a1[1]; a[6] = a1[2]; a[7] = a1[3];
            vf[d2][kb] = a;
          }
        __builtin_amdgcn_sched_barrier(0);
#pragma unroll
        for (int d2 = 0; d2 < 2; ++d2)
#pragma unroll
          for (int kb = 0; kb < 2; ++kb) {
            if (MODE == 2 && (2 * kb + 1 < mlo || 2 * kb > mhi)) continue;
#pragma unroll
            for (int u = 0; u < U; ++u)
              oacc[2 * hf + d2][u] = __builtin_amdgcn_mfma_f32_16x16x32_bf16(vf[d2][kb], pf[u][kb], oacc[2 * hf + d2][u], 0, 0, 0);
          }
        __builtin_amdgcn_sched_barrier(0);
      }
    }
    }
    if (kt + 1 < nt) lstore(buf ^ 1);
    __syncthreads();
  }
#pragma unroll
  for (int u = 0; u < U; ++u) {
    float l = lsum[u];
    l += __shfl_xor(l, 16); l += __shfl_xor(l, 32);
    float inv = 1.f / l;
    int qrow = qrow0 + 16 * u + l15;
#pragma unroll
    for (int d = 0; d < 4; ++d) {
      bf16x4 o;
#pragma unroll
      for (int e = 0; e < 4; ++e) o[e] = (short)f2bf(oacc[d][u][e] * inv);
      *(bf16x4*)(p.U + (size_t)qrow * D_ + h * 64 + 16 * d + 4 * lg) = o;
    }
  }
}

template <bool EMIT>
__device__ __forceinline__ void s5_scan_item(const Params& p, int item, float* smem) {
  const int tid = vtid(), lane = tid & 63, wv = tid >> 6;
  float* hs = smem + wv * 4640;
  float* Cs = hs + 2080;
  float* zs = Cs + 2304;
  int wi = item * 4 + wv;
  int c = wi % 68; int g = (wi / 68) & 31; int d = (wi / (68 * 32)) & 1; int b = wi / (68 * 64);
  int dg = d * 32 + g;
  int n = lane;
  float lr = p.lamb[(dg * 64 + n) * 2], li = p.lamb[(dg * 64 + n) * 2 + 1];
  float bbr[16], bbi[16];
#pragma unroll
  for (int cc = 0; cc < 16; ++cc) { bbr[cc] = p.bbar[((dg * 64 + n) * 16 + cc) * 2]; bbi[cc] = p.bbar[((dg * 64 + n) * 16 + cc) * 2 + 1]; }
  float hr = 0.f, hi = 0.f;
  u16* hsb = (u16*)hs;
  bf16x8 cfr[4];
  if (EMIT) {
    hr = p.chst[((size_t)wi * 64 + n) * 2]; hi = p.chst[((size_t)wi * 64 + n) * 2 + 1];
    const int ch = lane & 15, lg4 = lane >> 4;
#pragma unroll
    for (int ks = 0; ks < 4; ++ks) {
      float4 cr = *(const float4*)(p.in[20] + (dg * 16 + ch) * 64 + 16 * ks + 4 * lg4);
      float4 ci = *(const float4*)(p.in[21] + (dg * 16 + ch) * 64 + 16 * ks + 4 * lg4);
      u32x4 pk;
      pk[0] = pack_bf16(cr.x, -ci.x); pk[1] = pack_bf16(cr.y, -ci.y); pk[2] = pack_bf16(cr.z, -ci.z); pk[3] = pack_bf16(cr.w, -ci.w);
      cfr[ks] = __builtin_bit_cast(bf16x8, pk);
    }
  }
  for (int sc = 0; sc < 4; ++sc) {
    {
      int st = lane >> 2, q4 = lane & 3;
      int row = b * PB + pos_of(d, c * 64 + sc * 16 + st);
      float4 zv = *(const float4*)(p.z + (size_t)row * 512 + g * 16 + q4 * 4);
      *(float4*)(zs + st * 16 + q4 * 4) = zv;
    }
    __syncthreads();
#pragma unroll 4
    for (int st = 0; st < 16; ++st) {
      float4 z0 = *(const float4*)(zs + st * 16), z1 = *(const float4*)(zs + st * 16 + 4);
      float4 z2 = *(const float4*)(zs + st * 16 + 8), z3 = *(const float4*)(zs + st * 16 + 12);
      float zz[16] = {z0.x, z0.y, z0.z, z0.w, z1.x, z1.y, z1.z, z1.w, z2.x, z2.y, z2.z, z2.w, z3.x, z3.y, z3.z, z3.w};
      float bur = 0.f, bui = 0.f;
#pragma unroll
      for (int cc = 0; cc < 16; ++cc) { bur += bbr[cc] * zz[cc]; bui += bbi[cc] * zz[cc]; }
      float nr = lr * hr - li * hi + bur;
      float ni = lr * hi + li * hr + bui;
      hr = nr; hi = ni;
      if (EMIT) { *(unsigned*)(hsb + st * 136 + 2 * n) = pack_bf16(hr, hi); }
    }
    __syncthreads();
    if (EMIT) {
      const int l15 = lane & 15, lg4 = lane >> 4;
      f32x4 ya = (f32x4){0.f, 0.f, 0.f, 0.f};
#pragma unroll
      for (int ks = 0; ks < 4; ++ks) {
        bf16x8 a = *(const bf16x8*)(hsb + l15 * 136 + 32 * ks + 8 * lg4);
        ya = __builtin_amdgcn_mfma_f32_16x16x32_bf16(a, cfr[ks], ya, 0, 0, 0);
      }
#pragma unroll
      for (int rr = 0; rr < 4; ++rr) {
        int row = b * PB + pos_of(d, c * 64 + sc * 16 + 4 * lg4 + rr);
        __builtin_nontemporal_store(ya[rr], p.yd + ((size_t)d * T_ + row) * 512 + g * 16 + l15);
      }
      __syncthreads();
    }
  }
  if (!EMIT) { p.chst[((size_t)wi * 64 + n) * 2] = hr; p.chst[((size_t)wi * 64 + n) * 2 + 1] = hi; }
}

__device__ __forceinline__ void s5_combine_item(const Params& p, int item) {
  const int lane = tidx() & 63, wv = tidx() >> 6;
  int wi = item * 8 + wv;
  int g = wi & 31, d = (wi >> 5) & 1;
  int dg = d * 32 + g;
  float lr = p.lamb[(dg * 64 + lane) * 2], li = p.lamb[(dg * 64 + lane) * 2 + 1];
#pragma unroll
  for (int i = 0; i < 6; ++i) { float nr = lr * lr - li * li, ni = 2.f * lr * li; lr = nr; li = ni; }
  float Hr = 0.f, Hi = 0.f;
  for (int c = 0; c < 68; ++c) {
    size_t idx = (((size_t)wi * 68 + c) * 64 + lane) * 2;
    float a = p.chst[idx], bq = p.chst[idx + 1];
    p.chst[idx] = Hr; p.chst[idx + 1] = Hi;
    float nr = lr * Hr - li * Hi + a, ni = lr * Hi + li * Hr + bq;
    Hr = nr; Hi = ni;
  }
}

__device__ __forceinline__ void s5_gelu_phase(const Params& p) {
  const float* dsk = p.in[22];
  size_t total = (size_t)T_ * 512 / 4;
  for (size_t e = (size_t)bidx() * 512 + tidx(); e < total; e += (size_t)gridDim.x * 512) {
    size_t idx = e * 4; int c = (int)(idx & 511);
    f32x4 zq = __builtin_nontemporal_load((const f32x4*)(p.z + idx));
    f32x4 yq0 = __builtin_nontemporal_load((const f32x4*)(p.yd + idx)), yq1 = __builtin_nontemporal_load((const f32x4*)(p.yd + (size_t)T_ * 512 + idx));
    float4 zv = make_float4(zq[0], zq[1], zq[2], zq[3]), y0 = make_float4(yq0[0], yq0[1], yq0[2], yq0[3]), y1 = make_float4(yq1[0], yq1[1], yq1[2], yq1[3]);
    float4 dv = *(const float4*)(dsk + c);
    bf16x4 o;
    o[0] = (short)f2bf(geluf_(zv.x * dv.x + y0.x + y1.x)); o[1] = (short)f2bf(geluf_(zv.y * dv.y + y0.y + y1.y));
    o[2] = (short)f2bf(geluf_(zv.z * dv.z + y0.z + y1.z)); o[3] = (short)f2bf(geluf_(zv.w * dv.w + y0.w + y1.w));
    *(bf16x4*)(p.U + idx) = o;
  }
}

__device__ __forceinline__ void hg_scan_item(const Params& p, int item, int half, u16* smem) {
  constexpr int QLD = 136, TLD = 72;
  const int tid = tidx(), lane = tid & 63, wv = tid >> 6;
  const bool mma = wv < 4;
  const int l15 = lane & 15, lg = lane >> 4;
  u16* sQ = smem;
  u16* sK = sQ + 64 * QLD;
  u16* sKT = sK + 64 * QLD;
  u16* sVt = sKT + 128 * TLD;
  u16* sST = sVt + 32 * TLD;
  float* sEb = (float*)(sST + 32 * QLD);
  int vs = item & 3, d = (item >> 2) & 1, h = (item >> 3) & 7, bl = item >> 6;
  const size_t rbase = (size_t)bl * PB;
  const u16* lfp = p.hlf + (size_t)d * HR * 1024;
  u16* op = p.ho + (size_t)d * HR * 1024;
  f32x4 Sacc[2][2];
#pragma unroll
  for (int a = 0; a < 2; ++a)
#pragma unroll
    for (int c = 0; c < 2; ++c) Sacc[a][c] = (f32x4){0.f, 0.f, 0.f, 0.f};
  for (int e = tid; e < 32 * QLD; e += 512) sST[e] = 0;
  __syncthreads();
  float* sTot = sEb + 128;
  u16* sLF = sK;
  bf16x8 rq[2], rlf[2], rvv;
  auto prefetch = [&](int ch) {
#pragma unroll
    for (int i = 0; i < 2; ++i) {
      int id = tid + 512 * i; int s = id >> 4, c = id & 15;
      size_t row = rbase + pos_of(d, ch * 64 + s);
      rq[i] = *(const bf16x8*)(p.hq + row * 1024 + h * 128 + c * 8);
      rlf[i] = *(const bf16x8*)(lfp + row * 1024 + h * 128 + c * 8);
    }
    if (tid < 256) {
      int s = tid >> 2, c = tid & 3;
      size_t row = rbase + pos_of(d, ch * 64 + s);
      rvv = *(const bf16x8*)(p.hv + row * 1024 + h * 128 + vs * 32 + c * 8);
    }
  };
  prefetch(0);
  for (int ch = 0; ch < 68; ++ch) {
#pragma unroll
    for (int i = 0; i < 2; ++i) {
      int id = tid + 512 * i; int s = id >> 4, c = id & 15;
      *(bf16x8*)(sQ + s * QLD + c * 8) = rq[i];
      *(bf16x8*)(sLF + s * QLD + c * 8) = rlf[i];
    }
    if (tid < 256) {
      int s = tid >> 2, c = tid & 3;
#pragma unroll
      for (int e = 0; e < 8; ++e) sVt[(c * 8 + e) * TLD + s] = (u16)rvv[e];
    }
    __syncthreads();
    if (ch + 1 < 68) prefetch(ch + 1);
    {
      const int j = tid & 127, sg = tid >> 7;
      float fv[16], pr[16];
      float run = 1.f;
#pragma unroll
      for (int e = 0; e < 16; ++e) {
        float lf = __half2float(__ushort_as_half(sLF[(16 * sg + e) * QLD + j]));
        fv[e] = __expf(lf);
        run *= fv[e];
        pr[e] = run;
      }
      sTot[sg * 128 + j] = run;
      __syncthreads();
      float p0 = sTot[j], p1 = sTot[128 + j], p2 = sTot[256 + j], p3 = sTot[384 + j];
      float scale = (sg == 0) ? 1.f : (sg == 1) ? p0 : (sg == 2) ? p0 * p1 : p0 * p1 * p2;
      if (sg == 0) sEb[j] = p0 * p1 * p2 * p3;
#pragma unroll
      for (int e8 = 0; e8 < 16; e8 += 8) {
        bf16x8 kt8;
#pragma unroll
        for (int e = 0; e < 8; ++e) {
          int s = 16 * sg + e8 + e;
          float eb = pr[e8 + e] * scale;
          float kin = (1.f - fv[e8 + e]) * __builtin_amdgcn_rcpf(eb);
          float qv = bf2f(sQ[s * QLD + j]);
          sQ[s * QLD + j] = f2bf(qv * eb);
          u16 kb = f2bf(kin);
          sK[s * QLD + j] = kb;
          kt8[e] = (short)kb;
        }
        *(bf16x8*)(sKT + j * TLD + 16 * sg + e8) = kt8;
      }
    }
    __syncthreads();
    if (mma) {
    bf16x8 qfr[4], kfr[2][4], vop[2][2], stf[2][4], ktf[2][2], vbf[2][2];
    f32x4 att[4];
#pragma unroll
    for (int ks = 0; ks < 4; ++ks) qfr[ks] = *(const bf16x8*)(sQ + (16 * wv + l15) * QLD + ks * 32 + lg * 8);
#pragma unroll
    for (int ms = 0; ms < 2; ++ms)
#pragma unroll
      for (int ks = 0; ks < 4; ++ks) kfr[ms][ks] = *(const bf16x8*)(sK + (16 * ms + l15) * QLD + ks * 32 + lg * 8);
#pragma unroll
    for (int md = 0; md < 2; ++md)
#pragma unroll
      for (int kb = 0; kb < 2; ++kb) ktf[md][kb] = *(const bf16x8*)(sKT + (32 * wv + 16 * md + l15) * TLD + kb * 32 + lg * 8);
#pragma unroll
    for (int nv = 0; nv < 2; ++nv)
#pragma unroll
      for (int kb = 0; kb < 2; ++kb) vbf[nv][kb] = *(const bf16x8*)(sVt + (16 * nv + l15) * TLD + kb * 32 + lg * 8);
    __builtin_amdgcn_sched_barrier(0);
#pragma unroll
    for (int ms = 0; ms < 2; ++ms) {
      att[ms] = (f32x4){0.f, 0.f, 0.f, 0.f};
#pragma unroll
      for (int ks = 0; ks < 4; ++ks) att[ms] = __builtin_amdgcn_mfma_f32_16x16x32_bf16(kfr[ms][ks], qfr[ks], att[ms], 0, 0, 0);
    }
#pragma unroll
    for (int md = 0; md < 2; ++md)
#pragma unroll
      for (int kb = 0; kb < 2; ++kb)
#pragma unroll
        for (int nv = 0; nv < 2; ++nv)
          Sacc[md][nv] = __builtin_amdgcn_mfma_f32_16x16x32_bf16(ktf[md][kb], vbf[nv][kb], Sacc[md][nv], 0, 0, 0);
    __builtin_amdgcn_sched_barrier(0);
#pragma unroll
    for (int ms = 0; ms < 2; ++ms)
#pragma unroll
      for (int ks = 0; ks < 4; ++ks) kfr[ms][ks] = *(const bf16x8*)(sK + (16 * (2 + ms) + l15) * QLD + ks * 32 + lg * 8);
#pragma unroll
    for (int nv = 0; nv < 2; ++nv) {
#pragma unroll
      for (int kb = 0; kb < 2; ++kb) {
        const u16* vp = sVt + (16 * nv + l15) * TLD + 32 * kb + 4 * lg;
        bf16x4 a0 = *(const bf16x4*)vp, a1 = *(const bf16x4*)(vp + 16);
        bf16x8 a;
        a[0] = a0[0]; a[1] = a0[1]; a[2] = a0[2]; a[3] = a0[3]; a[4] = a1[0]; a[5] = a1[1]; a[6] = a1[2]; a[7] = a1[3];
        vop[nv][kb] = a;
      }
#pragma unroll
      for (int ks = 0; ks < 4; ++ks) stf[nv][ks] = *(const bf16x8*)(sST + (16 * nv + l15) * QLD + ks * 32 + lg * 8);
    }
    __builtin_amdgcn_sched_barrier(0);
#pragma unroll
    for (int ms = 0; ms < 2; ++ms) {
      att[2 + ms] = (f32x4){0.f, 0.f, 0.f, 0.f};
#pragma unroll
      for (int ks = 0; ks < 4; ++ks) att[2 + ms] = __builtin_amdgcn_mfma_f32_16x16x32_bf16(kfr[ms][ks], qfr[ks], att[2 + ms], 0, 0, 0);
    }
    f32x4 oacc[2];
#pragma unroll
    for (int nv = 0; nv < 2; ++nv) {
      oacc[nv] = (f32x4){0.f, 0.f, 0.f, 0.f};
#pragma unroll
      for (int ks = 0; ks < 4; ++ks) oacc[nv] = __builtin_amdgcn_mfma_f32_16x16x32_bf16(stf[nv][ks], qfr[ks], oacc[nv], 0, 0, 0);
    }
    bf16x8 pfr[2];
    {
      int t = 16 * wv + l15;
#pragma unroll
      for (int ms = 0; ms < 4; ++ms)
#pragma unroll
        for (int rr = 0; rr < 4; ++rr) {
          int s = 16 * ms + 4 * lg + rr;
          float v = (s <= t) ? att[ms][rr] : 0.f;
          pfr[ms >> 1][(ms & 1) * 4 + rr] = (short)f2bf(v);
        }
    }
#pragma unroll
    for (int nv = 0; nv < 2; ++nv)
#pragma unroll
      for (int kb = 0; kb < 2; ++kb) oacc[nv] = __builtin_amdgcn_mfma_f32_16x16x32_bf16(vop[nv][kb], pfr[kb], oacc[nv], 0, 0, 0);
    {
      int t = 16 * wv + l15;
      size_t row = rbase + pos_of(d, ch * 64 + t);
#pragma unroll
      for (int nv = 0; nv < 2; ++nv) {
        bf16x4 o;
#pragma unroll
        for (int e = 0; e < 4; ++e) o[e] = (short)f2bf(oacc[nv][e]);
        *(bf16x4*)(op + row * 1024 + h * 128 + vs * 32 + 16 * nv + 4 * lg) = o;
      }
    }
    }
    __syncthreads();
    if (mma) {
#pragma unroll
    for (int md = 0; md < 2; ++md) {
      int d0 = 32 * wv + 16 * md + 4 * lg;
      float4 eb = *(const float4*)(sEb + d0);
#pragma unroll
      for (int nv = 0; nv < 2; ++nv) {
        Sacc[md][nv][0] *= eb.x; Sacc[md][nv][1] *= eb.y; Sacc[md][nv][2] *= eb.z; Sacc[md][nv][3] *= eb.w;
        bf16x4 o;
#pragma unroll
        for (int e = 0; e < 4; ++e) o[e] = (short)f2bf(Sacc[md][nv][e]);
        *(bf16x4*)(sST + (16 * nv + l15) * QLD + d0) = o;
      }
    }
    }
    __syncthreads();
  }
}

__device__ __forceinline__ void hg_readout_phase(const Params& p, int half) {
  int lane = tidx() & 63, wv = tidx() >> 6;
  const float* ng = p.in[26];
  for (int rl = bidx() * 8 + wv; rl < HR; rl += gridDim.x * 8) {
    size_t o = (size_t)rl * 1024 + lane * 16;
    bf16x8 a0 = *(const bf16x8*)(p.ho + o), a1 = *(const bf16x8*)(p.ho + o + 8);
    bf16x8 b0 = *(const bf16x8*)(p.ho + (size_t)HR * 1024 + o), b1 = *(const bf16x8*)(p.ho + (size_t)HR * 1024 + o + 8);
    bf16x8 g0 = *(const bf16x8*)(p.hsg + o), g1 = *(const bf16x8*)(p.hsg + o + 8);
    float v[16]; float ss = 0.f;
#pragma unroll
    for (int e = 0; e < 8; ++e) {
      v[e] = bf2f((u16)a0[e]) + bf2f((u16)b0[e]);
      v[8 + e] = bf2f((u16)a1[e]) + bf2f((u16)b1[e]);
    }
#pragma unroll
    for (int e = 0; e < 16; ++e) ss += v[e] * v[e];
    ss += __shfl_xor(ss, 1); ss += __shfl_xor(ss, 2); ss += __shfl_xor(ss, 4);
    float rstd = rsqrtf(ss * (1.f / 128.f) + EPS);
    bf16x8 o0, o1;
#pragma unroll
    for (int e = 0; e < 8; ++e) {
      o0[e] = (short)f2bf(v[e] * rstd * ng[lane * 16 + e] * bf2f((u16)g0[e]));
      o1[e] = (short)f2bf(v[8 + e] * rstd * ng[lane * 16 + 8 + e] * bf2f((u16)g1[e]));
    }
    size_t uo = ((size_t)half * HR + rl) * 1024 + lane * 16;
    *(bf16x8*)(p.U + uo) = o0; *(bf16x8*)(p.U + uo + 8) = o1;
  }
}

__device__ __forceinline__ void convgate_phase(const Params& p, int layer) {
  const float* cw = p.in[32] + (size_t)layer * 3 * F2;
  const float* cb = p.in[33] + (size_t)layer * F2;
  const size_t total = (size_t)HR * (F_ / 8);
  for (size_t e = (size_t)bidx() * 512 + tidx(); e < total; e += (size_t)gridDim.x * 512) {
    int rl = (int)(e / (F_ / 8)); int f = (int)(e % (F_ / 8)) * 8;
    int pp = rl % PB;
    bool hasp = (pp != 0) && (pp != CTX);
    bool hasn = (pp != CTX - 1) && (pp != PB - 1);
    const u16* hrow = p.H + (size_t)rl * F2;
    float a[8], gq[8];
#pragma unroll
    for (int part = 0; part < 2; ++part) {
      int fo = f + part * F_;
      bf16x8 c1 = *(const bf16x8*)(hrow + fo);
      bf16x8 c0 = c1, c2 = c1;
      if (hasp) c0 = *(const bf16x8*)(hrow - F2 + fo);
      if (hasn) c2 = *(const bf16x8*)(hrow + F2 + fo);
      float* dst = part == 0 ? a : gq;
#pragma unroll
      for (int k = 0; k < 8; ++k) {
        float v = bf2f((u16)c1[k]) * cw[F2 + fo + k] + cb[fo + k];
        if (hasp) v += bf2f((u16)c0[k]) * cw[fo + k];
        if (hasn) v += bf2f((u16)c2[k]) * cw[2 * F2 + fo + k];
        dst[k] = v;
      }
    }
    bf16x8 o;
#pragma unroll
    for (int k = 0; k < 8; ++k) o[k] = (short)f2bf(a[k] * siluf_(gq[k]));
    *(bf16x8*)(p.act + (size_t)rl * F_ + f) = o;
  }
}

constexpr int SMEM_BYTES = 74240;
enum { T_PREP = 0, T_NORM, T_GEMM, T_LATNORM, T_ATTN_MLA, T_S5A, T_S5B, T_S5C, T_S5GELU, T_HGSCAN, T_HGRO, T_ATTN_NA, T_CONVGATE, T_FINAL, T_NONE };
struct PD { int type, layer, set, half; GA g, g2; };

__device__ __forceinline__ void get_phase(const Params& p, int target, PD& pd) {
  int ph = 0;
  pd.type = T_NONE; pd.layer = 0; pd.set = 0; pd.half = 0;
  pd.g = GA{}; pd.g2 = GA{};
#define AT(code) { if (ph == target) { code } ++ph; }
  AT(pd.type = T_PREP;)
  for (int layer = 0; layer < 4; ++layer) {
    AT(pd.type = T_NORM; pd.layer = layer; pd.set = 0;)
    if (layer == 0) {
      AT(pd.type = T_GEMM; GA& g = pd.g; g.A = p.U; g.lda = 1024; g.Bt = p.w_mla_in; g.K = 1024; g.mt = T_ / 256; g.nt = 3; g.mode = E_LAT; g.o0 = p.lat;)
      AT(pd.type = T_LATNORM;)
      AT(pd.type = T_GEMM; GA& g = pd.g; g.A = p.qn; g.lda = 384; g.Bt = p.w_mla_q; g.K = 384; g.mt = T_ / 256; g.nt = 6; g.mode = E_BF16; g.o0 = p.Qm; g.ldo = 1536;
         GA& g2 = pd.g2; g2.A = p.kvn; g2.lda = 256; g2.Bt = p.w_mla_kv; g2.K = 256; g2.mt = T_ / 256; g2.nt = 8; g2.mode = E_KV; g2.o0 = p.Kn; g2.o1 = p.Vm;)
      AT(pd.type = T_ATTN_MLA;)
      AT(pd.type = T_GEMM; GA& g = pd.g; g.A = p.U; g.lda = 1024; g.Bt = p.w_mla_out; g.K = 1024; g.mt = T_ / 256; g.nt = 4; g.mode = E_RES; g.layer = 0; g.set = 0;)
    } else if (layer == 1) {
      AT(pd.type = T_GEMM; GA& g = pd.g; g.A = p.U; g.lda = 1024; g.Bt = p.w_s5_in; g.K = 1024; g.mt = T_ / 256; g.nt = 2; g.mode = E_F32; g.o0 = p.z; g.ldo = 512;)
      AT(pd.type = T_S5A;)
      AT(pd.type = T_S5B;)
      AT(pd.type = T_S5C;)
      AT(pd.type = T_S5GELU;)
      AT(pd.type = T_GEMM; GA& g = pd.g; g.A = p.U; g.lda = 512; g.Bt = p.w_s5_glu; g.K = 512; g.mt = T_ / 256; g.nt = 8; g.mode = E_GLU; g.layer = 1; g.set = 0;)
    } else if (layer == 2) {
      for (int half = 0; half < 2; ++half) {
        AT(pd.type = T_GEMM; GA& g = pd.g; g.A = p.U; g.lda = 1024; g.Bt = p.w_hg_in; g.K = 1024; g.row0 = half * HR; g.mt = HR / 256; g.nt = 20; g.mode = E_HG; g.orb = half * HR;)
        AT(pd.type = T_HGSCAN; pd.half = half;)
        AT(pd.type = T_HGRO; pd.half = half;)
      }
      AT(pd.type = T_GEMM; GA& g = pd.g; g.A = p.U; g.lda = 1024; g.Bt = p.w_hg_out; g.K = 1024; g.mt = T_ / 256; g.nt = 4; g.mode = E_RES; g.layer = 2; g.set = 0;)
    } else {
      AT(pd.type = T_GEMM; GA& g = pd.g; g.A = p.U; g.lda = 1024; g.Bt = p.w_na_qkv; g.K = 1024; g.mt = T_ / 256; g.nt = 12; g.mode = E_BF16; g.o0 = p.QKV; g.ldo = 3072;)
      AT(pd.type = T_ATTN_NA;)
      AT(pd.type = T_GEMM; GA& g = pd.g; g.A = p.U; g.lda = 1024; g.Bt = p.w_na_out; g.K = 1024; g.mt = T_ / 256; g.nt = 4; g.mode = E_RES; g.layer = 3; g.set = 0;)
    }
    AT(pd.type = T_NORM; pd.layer = layer; pd.set = 1;)
    AT(pd.type = T_GEMM; GA& g = pd.g; g.A = p.U; g.lda = 1024; g.Bt = p.w_up[layer]; g.K = 1024; g.mt = 138; g.nt = 22; g.mode = E_FFNUP; g.layer = layer;)
    AT(pd.type = T_GEMM; GA& g = pd.g; g.A = p.act; g.lda = F_; g.Bt = p.w_down[layer]; g.K = F_; g.mt = T_ / 256; g.nt = 4; g.mode = E_RES; g.layer = layer; g.set = 1;)
  }
  AT(pd.type = T_FINAL;)
#undef AT
}


#define XB_TMO      128
#define XB_XCNT(j)  (256  + 64 * (j))
#define XB_XSUB(j)  (1280 + 64 * (j))
#define XB_XGEN(j)  (2304 + 64 * (j))
#define XB_TOP      3328
#define XB_TOPGEN   3392
#define XCD_BAR_WORDS 3456
#define XB_SPIN_CAP (1u << 23)
#define LAS __attribute__((address_space(3)))
__device__ __forceinline__ unsigned xb_ld(unsigned* p) { return __hip_atomic_load(p, __ATOMIC_RELAXED, __HIP_MEMORY_SCOPE_AGENT); }
__device__ __forceinline__ unsigned xb_add(unsigned* p, unsigned v) { return __hip_atomic_fetch_add(p, v, __ATOMIC_RELAXED, __HIP_MEMORY_SCOPE_AGENT); }
__device__ __forceinline__ unsigned xb_xcc_id() { return (unsigned)__builtin_amdgcn_s_getreg((3 << 11) | 20) & 0xFu; }
#define XB_SPIN(cond, bar) do { unsigned _sp = 0; while (cond) { __builtin_amdgcn_s_sleep(1); \
    if ((++_sp & 255u) == 0u) { if (xb_ld(&(bar)[XB_TMO])) break; if (_sp > XB_SPIN_CAP) { atomicAdd(&(bar)[XB_TMO], 1u); break; } } } } while (0)
struct XcdBarrier { unsigned* bar; unsigned x; volatile LAS unsigned* st; };
__device__ __forceinline__ XcdBarrier xcd_barrier_post(unsigned* bar, volatile LAS unsigned* st) {
  XcdBarrier b; b.bar = bar; b.x = xb_xcc_id(); b.st = st;
  if (threadIdx.x == 0) (void)xb_add(&bar[XB_XCNT(b.x)], 1u);
  return b;
}
__device__ __forceinline__ void xcd_barrier_complete(unsigned* bar, unsigned x, unsigned& nloc, unsigned& nx) {
  const unsigned G = gridDim.x * gridDim.y * gridDim.z;
  unsigned sum, cnt, mine, sp = 0u;
  for (;;) {
    sum = 0u; cnt = 0u; mine = 0u;
#pragma unroll
    for (unsigned j = 0; j < 16; ++j) { const unsigned c = xb_ld(&bar[XB_XCNT(j)]); sum += c; cnt += (c > 0u) ? 1u : 0u; mine = (j == x) ? c : mine; }
    if (sum == G) break;
    __builtin_amdgcn_s_sleep(1);
    if ((++sp & 255u) == 0u) { if (xb_ld(&bar[XB_TMO])) break; if (sp > XB_SPIN_CAP) { atomicAdd(&bar[XB_TMO], 1u); break; } }
  }
  nloc = mine > 0u ? mine : 1u; nx = cnt > 0u ? cnt : 1u;
}
__device__ __forceinline__ void xcd_barrier(const XcdBarrier& b) {
  asm volatile("s_waitcnt vmcnt(0)" ::: "memory");
  __syncthreads();
  if (threadIdx.x == 0) {
    unsigned* bar = b.bar;
    __builtin_amdgcn_s_waitcnt(0);
    unsigned nloc = b.st[0], nx = b.st[1];
    if (nloc == 0u) { xcd_barrier_complete(bar, b.x, nloc, nx); b.st[0] = nloc; b.st[1] = nx; }
    const unsigned old = xb_add(&bar[XB_XSUB(b.x)], 1u);
    const unsigned gen = old / nloc;
    if (old + 1u == (gen + 1u) * nloc) {
      __builtin_amdgcn_fence(__ATOMIC_RELEASE, "agent");
      asm volatile("s_waitcnt vmcnt(0)" ::: "memory");
      const unsigned og = xb_add(&bar[XB_TOP], 1u);
      const unsigned tg = og / nx;
      if (og + 1u == (tg + 1u) * nx) xb_add(&bar[XB_TOPGEN], 1u);
      else XB_SPIN(xb_ld(&bar[XB_TOPGEN]) == tg, bar);
      __builtin_amdgcn_fence(__ATOMIC_ACQUIRE, "agent");
      xb_add(&bar[XB_XGEN(b.x)], 1u);
      asm volatile("s_waitcnt vmcnt(0)" ::: "memory");
    } else {
      XB_SPIN(xb_ld(&bar[XB_XGEN(b.x)]) == gen, bar);
      __builtin_amdgcn_fence(__ATOMIC_ACQUIRE, "agent");
      asm volatile("s_waitcnt vmcnt(0)" ::: "memory");
    }
  }
  __syncthreads();
}

constexpr int SMEM_HALF = 74240;
#define VLOOP(n, call, ndry) \
  for (int k_ = 0; k_ * VG < (n); ++k_) { int it = vbid + k_ * VG; \
    if (it < (n)) { call; } else { for (int q_ = 0; q_ < (ndry); ++q_) __syncthreads(); } }

__global__ void __launch_bounds__(512, 2) mega(Params p, int ph_lo, int ph_hi) {
  cg::grid_group grid = cg::this_grid();
  __shared__ __attribute__((aligned(16))) unsigned char smem_raw[2 * SMEM_HALF + 16];
  u16* smem = (u16*)smem_raw;
  const int G = gridDim.x, bid = bidx();
  volatile LAS unsigned* xst = (volatile LAS unsigned*)(smem_raw + 2 * SMEM_HALF);
  if (threadIdx.x == 0) { xst[0] = 0u; xst[1] = 0u; }
  __syncthreads();
  XcdBarrier xb = xcd_barrier_post(p.bar, xst);
  for (int ph = ph_lo; ph < ph_hi; ++ph) {
    if (ph > ph_lo) { if (ph == ph_lo + 1) grid.sync(); else xcd_barrier(xb); }
    PD pd;
    get_phase(p, ph, pd);
    pd.g.scale = 1.f; pd.g2.scale = 1.f;
    const int vh = tidx() >> 8;
    const int vbid = bid * 2 + vh, VG = 2 * G;
    u16* smh = (u16*)(smem_raw + vh * SMEM_HALF);
    float* smfh = (float*)smh;
#ifdef PROBE_MASK
    const int reps = ((PROBE_MASK >> pd.type) & 1) ? 2 : 1;
    for (int rep = 0; rep < reps; ++rep) {
    if (rep > 0) { grid.sync(); pd.g.scale = 0.f; pd.g2.scale = 0.f; }
#endif
    switch (pd.type) {
      case T_PREP: {
        VLOOP(p.ntt, prep_transpose(p, it, smfh), 2)
        VLOOP(384, prep_mod(p, it, smfh), 3)
        VLOOP(17, prep_small(p, it), 0)
      } break;
      case T_NORM: modnorm_phase(p, pd.layer, pd.set, pd.set == 0 ? p.in[6] : p.in[7], (G == 256 && pd.set == 0 && pd.layer > 0) ? pd.layer - 1 : -1); break;
      case T_GEMM: {
        int t1 = pd.g.mt * pd.g.nt, t2 = pd.g2.mt * pd.g2.nt;
        int nall = t1 + t2;
        const bool splitk = (pd.g.mode == E_RES) && (pd.g.K == F_) && (t1 == 544) && (t2 == 0) && (G == 256);
        if (splitk) nall = 512;
        int chunk = (nall + 7) >> 3;
        int xcd = bid & 7, bl = bid >> 3, gl = G >> 3;
        int vend = min((xcd + 1) * chunk, nall);
        for (int v = xcd * chunk + bl; v < vend; v += gl) {
          bool first = v < t1;
          GA cur = first ? pd.g : pd.g2;
          int vv = first ? v : v - t1;
          int per = 8 * cur.nt;
          int sr = vv / per, rem = vv - sr * per;
          int full = cur.mt >> 3;
          int tn, tm;
          if (sr < full) { tn = rem >> 3; tm = sr * 8 + (rem & 7); }
          else { int rl = cur.mt & 7; tn = rem / rl; tm = full * 8 + (rem - tn * rl); }
          gemm_tile(p, cur, tm, tn, smem);
        }
        if (splitk) {
          GA cur = pd.g;
          int tile = bid >> 3, c = bid & 7;
          int tn = tile >> 3, tm = 128 + (tile & 7);
          int nks = cur.K >> 6;
          cur.kb = (c * nks) >> 3; cur.ke = ((c + 1) * nks) >> 3;
          cur.mode = E_PART; cur.o0 = (cur.layer == 3 ? p.part3 : p.part0) + (size_t)c * 2048 * 1024; cur.orb = 32768;
          gemm_tile(p, cur, tm, tn, smem);
        }
      } break;
      case T_LATNORM: latnorm_phase(p); break;
      case T_ATTN_MLA: {
        if (G == 256) {
          const int x = bid & 7, bl = bid >> 3;
          for (int k = 0; k < 8; ++k) attn_item<96, 2, 0, 8, 2>(p, (k * 16 + x * 2 + (bl >> 4)) * 16 + (bl & 15), smem);
        } else {
          for (int it = bid; it < 2048; it += G) attn_item<96, 2, 0, 8, 2>(p, it, smem);
        }
        for (int it = bid; it < 128; it += G) attn_item<96, 2, 1, 8, 2>(p, it, smem);
      } break;
      case T_S5A: { VLOOP(8704, s5_scan_item<false>(p, it, smfh), 8) } break;
      case T_S5B: for (int it = bid; it < 64; it += G) s5_combine_item(p, it); break;
      case T_S5C: { VLOOP(8704, s5_scan_item<true>(p, it, smfh), 12) } break;
      case T_S5GELU: s5_gelu_phase(p); break;
      case T_HGSCAN: {
        for (int it = bid; it < 256; it += G) {
          const int itx = (G == 256) ? ((((it & 7) * 8 + (it >> 5)) << 2) | ((it >> 3) & 3)) : it;
          hg_scan_item(p, itx, pd.half, smem);
        }
      } break;
      case T_HGRO: hg_readout_phase(p, pd.half); break;
      case T_ATTN_NA: {
        if (G == 256) {
          const int x = bid & 7, vb = (bid >> 3) * 2 + vh;
          for (int k = 0; k < 8; ++k) attn_item<64, 2, 2, 4, 1>(p, (k * 16 + x * 2 + (vb >> 5)) * 32 + (vb & 31), smh);
        } else { VLOOP(4096, (attn_item<64, 2, 2, 4, 1>(p, it, smh)), 14) }
      } break;
      case T_FINAL: final_norm_phase(p, G == 256); break;
      default: break;
    }
#ifdef PROBE_MASK
    }
#endif
  }
}

constexpr int N_PHASES = 39;

extern "C" void kernel_launch(void* const* d_in, const int* in_sizes, int n_in, void* d_out, int out_size,
                              void* d_ws, size_t ws_size, hipStream_t stream) {
  Params p;
  memset(&p, 0, sizeof(p));
  for (int i = 0; i < 36; ++i) p.in[i] = (const float*)d_in[i];
  p.out = (float*)d_out;
  char* ws = (char*)d_ws;
  size_t off = 0;
  auto take = [&](size_t bytes) { char* r = ws + off; off += (bytes + 255) & ~(size_t)255; return r; };
  p.bar = (unsigned*)take(XCD_BAR_WORDS * 4);
  p.X = (float*)take((size_t)T_ * D_ * 4);
  p.U = (u16*)take((size_t)T_ * D_ * 2);
  p.mod = (float*)take((size_t)4 * 9 * 6144 * 4);
  p.cs = (float*)take(4096);
  p.lb2 = (float*)take(4096);
  p.lamb = (float*)take(2 * 32 * 64 * 2 * 4);
  p.bbar = (float*)take(2 * 32 * 64 * 16 * 2 * 4);
  int ntd = 0, ntt = 0;
  auto addw = [&](const float* src, int K, int N, int Npad, int mode) -> u16* {
    u16* dst = (u16*)take((size_t)Npad * K * 2);
    p.td[ntd].src = src; p.td[ntd].dst = dst; p.td[ntd].K = K; p.td[ntd].N = N; p.td[ntd].Npad = Npad; p.td[ntd].mode = mode;
    ntt += (K / 64) * (Npad / 64); ++ntd;
    return dst;
  };
  p.w_mla_in = addw(p.in[8], 1024, 672, 768, 0);
  p.w_mla_q = addw(p.in[10], 384, 1536, 1536, 0);
  p.w_mla_kv = addw(p.in[12], 256, 2048, 2048, 0);
  p.w_mla_out = addw(p.in[13], 1024, 1024, 1024, 0);
  p.w_s5_in = addw(p.in[14], 1024, 512, 512, 0);
  p.w_s5_glu = addw(p.in[23], 512, 2048, 2048, 1);
  p.w_hg_in = addw(p.in[24], 1024, 5120, 5120, 0);
  p.w_hg_out = addw(p.in[27], 1024, 1024, 1024, 0);
  p.w_na_qkv = addw(p.in[28], 1024, 3072, 3072, 0);
  p.w_na_out = addw(p.in[30], 1024, 1024, 1024, 0);
  for (int i = 0; i < 4; ++i) {
    p.w_up[i] = addw(p.in[31] + (size_t)i * 1024 * F2, 1024, F2, F2, 2);
    p.w_down[i] = addw(p.in[34] + (size_t)i * F_ * 1024, F_, 1024, 1024, 0);
  }
  p.ntd = ntd; p.ntt = ntt;
  char* S = ws + off;
  char* O2 = (char*)d_out;
  p.lat = (float*)S; p.Qm = (u16*)S; p.Kn = (u16*)(S + (size_t)T_ * 1536 * 2);
  p.Vm = (u16*)O2; p.qn = (u16*)(O2 + (size_t)T_ * 1024 * 2); p.kvn = p.qn + (size_t)T_ * 384; p.kr = p.kvn + (size_t)T_ * 256;
  p.z = (float*)S; p.yd = (float*)(S + (size_t)T_ * 512 * 4); p.chst = (float*)O2; p.part0 = (float*)O2; p.part3 = (float*)p.U;
  p.hq = (u16*)S; p.hlf = p.hq + (size_t)HR * 1024; p.hv = p.hlf + (size_t)2 * HR * 1024; p.hsg = p.hv + (size_t)HR * 1024; p.ho = (u16*)O2;
  p.QKV = (u16*)S;
  p.H = (u16*)S; p.act = (u16*)S;

  static int grid_blocks = 0;
  if (!grid_blocks) {
    int dev = 0, cus = 0, per_cu = 0;
    (void)hipGetDevice(&dev);
    (void)hipDeviceGetAttribute(&cus, hipDeviceAttributeMultiprocessorCount, dev);
    (void)hipOccupancyMaxActiveBlocksPerMultiprocessor(&per_cu, mega, 512, 0);
    if (per_cu < 1) per_cu = 1;
    if (per_cu > 1) per_cu = 1;
    grid_blocks = cus * per_cu;
  }
  (void)hipMemsetAsync(p.bar, 0, XCD_BAR_WORDS * 4, stream);
#if ONE_LAUNCH
  int lo = 0, hi = N_PHASES;
  void* args[] = {&p, &lo, &hi};
  hipError_t e = hipLaunchCooperativeKernel((void*)mega, dim3(grid_blocks), dim3(512), args, 0, stream);
  if (e != hipSuccess) fprintf(stderr, "cooperative launch failed: %s (grid %d)\n", hipGetErrorString(e), grid_blocks);
#else
  for (int ph = 0; ph < N_PHASES; ++ph) {
    hipLaunchKernelGGL(mega, dim3(grid_blocks), dim3(512), 0, stream, p, ph, ph + 1);
  }
#endif
}
```

```cpp
#include <hip/hip_runtime.h>
#include <hip/hip_bf16.h>
#include <hip/hip_fp16.h>
#include <hip/hip_cooperative_groups.h>
#include <cstdio>
#include <cstring>
namespace cg = cooperative_groups;

#ifndef ONE_LAUNCH
#define ONE_LAUNCH 1
#endif

typedef __attribute__((ext_vector_type(8))) short bf16x8;
typedef __attribute__((ext_vector_type(4))) short bf16x4;
typedef __attribute__((ext_vector_type(4))) float f32x4;
typedef unsigned short u16;

constexpr int NB = 8, SEQ = 4096, CTX = 256, PB = 4352, T_ = 34816, D_ = 1024;
constexpr int F_ = 2816, F2 = 5632;
constexpr int HR = 17408;
constexpr float EPS = 1e-6f;
constexpr float LOG2E = 1.4426950408889634f;

struct TDesc { const float* src; u16* dst; int K, N, Npad, mode; };

struct Params {
  const float* in[36];
  float* out;
  unsigned* bar; float* part0; float* part3;
  float* X; u16* U; float* mod; float* cs; float* lb2; float* lamb; float* bbar;
  u16* w_mla_in; u16* w_mla_q; u16* w_mla_kv; u16* w_mla_out;
  u16* w_s5_in; u16* w_s5_glu; u16* w_hg_in; u16* w_hg_out; u16* w_na_qkv; u16* w_na_out;
  u16* w_up[4]; u16* w_down[4];
  float* lat; u16* Qm; u16* Kn; u16* Vm; u16* qn; u16* kvn; u16* kr;
  float* z; float* yd; float* chst;
  u16* hq; u16* hlf; u16* hv; u16* hsg; u16* ho;
  u16* QKV;
  u16* H; u16* act;
  TDesc td[20];
  int ntd; int ntt;
};

__device__ __forceinline__ int tidx() { int t = threadIdx.x; asm volatile("" : "+v"(t)); return t; }
__device__ __forceinline__ int vtid() { return tidx() & 255; }
__device__ __forceinline__ int bidx() { int t = blockIdx.x; asm volatile("" : "+s"(t)); return t; }
__device__ __forceinline__ u16 f2bf(float f) {
  unsigned u = __float_as_uint(f);
  u += 0x7fffu + ((u >> 16) & 1u);
  return (u16)(u >> 16);
}
typedef __attribute__((ext_vector_type(4))) unsigned u32x4;
typedef __attribute__((ext_vector_type(2))) float f32x2_t;
typedef __attribute__((ext_vector_type(2))) __bf16 bf16x2_t;
__device__ __forceinline__ unsigned pack_bf16(float a, float b) {
  f32x2_t v = {a, b};
  bf16x2_t r = __builtin_convertvector(v, bf16x2_t);
  return __builtin_bit_cast(unsigned, r);
}
__device__ __forceinline__ float vmax(float a, float b) { return __builtin_fmaxf(a, b); }
__device__ __forceinline__ float vmax3(float a, float b, float c) { return __builtin_fmaxf(__builtin_fmaxf(a, b), c); }
__device__ __forceinline__ float bf2f(u16 h) { return __uint_as_float(((unsigned)h) << 16); }
__device__ __forceinline__ float sigmoidf_(float x) { return 1.f / (1.f + __expf(-x)); }
__device__ __forceinline__ float siluf_(float x) { return x / (1.f + __expf(-x)); }
__device__ __forceinline__ float geluf_(float x) {
  float u = 0.7978845608028654f * (x + 0.044715f * x * x * x);
  return 0.5f * x * (1.f + tanhf(u));
}
__device__ __forceinline__ float wave_sum(float v) {
#pragma unroll
  for (int o = 32; o > 0; o >>= 1) v += __shfl_xor(v, o);
  return v;
}
__device__ __forceinline__ int brow_of(int row) {
  int b = row / PB; int pp = row - b * PB;
  return pp < CTX ? 8 : b;
}
__device__ __forceinline__ int pos_of(int d, int s) {
  return d == 0 ? s : (s < CTX ? (CTX - 1 - s) : (PB + CTX - 1 - s));
}

__device__ __forceinline__ const float* in_row(const Params& p, int row) {
  int b = row / PB, pp = row - b * PB;
  return (pp < CTX) ? (p.in[2] + ((size_t)b * CTX + pp) * D_) : (p.in[0] + ((size_t)b * SEQ + (pp - CTX)) * D_);
}
__device__ __forceinline__ int glu_map(int np, int halfn) {
  int tile = np >> 8, c = np & 255;
  int wn = c >> 6, s = (c & 63) >> 4;
  int f = tile * 128 + 32 * wn + 16 * (s & 1) + (c & 15);
  return f + ((s >= 2) ? halfn : 0);
}

__device__ __forceinline__ void prep_transpose(const Params& p, int item, float* ts) {
  int di = 0, rem = item;
  for (; di < p.ntd; ++di) {
    int nt = (p.td[di].K >> 6) * (p.td[di].Npad >> 6);
    if (rem < nt) break;
    rem -= nt;
  }
  const TDesc& t = p.td[di];
  int ntn = t.Npad >> 6;
  int kk0 = (rem / ntn) * 64, n0 = (rem % ntn) * 64;
  int tid = vtid();
#pragma unroll
  for (int i = 0; i < 4; ++i) {
    int kl = (tid >> 4) + 16 * i;
    int nl = (tid & 15) * 4;
    int np = n0 + nl;
    int sc = (t.mode == 1) ? glu_map(np, 1024) : ((t.mode == 2) ? glu_map(np, F_) : np);
    float4 v = make_float4(0.f, 0.f, 0.f, 0.f);
    if (np < t.N) { f32x4 t4 = __builtin_nontemporal_load((const f32x4*)(t.src + (size_t)(kk0 + kl) * t.N + sc)); v = make_float4(t4[0], t4[1], t4[2], t4[3]); }
    ts[(nl + 0) * 65 + kl] = v.x; ts[(nl + 1) * 65 + kl] = v.y;
    ts[(nl + 2) * 65 + kl] = v.z; ts[(nl + 3) * 65 + kl] = v.w;
  }
  __syncthreads();
  {
    int nl = tid >> 2, kq = (tid & 3) * 16;
    bf16x8 o0, o1;
#pragma unroll
    for (int e = 0; e < 8; ++e) { o0[e] = (short)f2bf(ts[nl * 65 + kq + e]); o1[e] = (short)f2bf(ts[nl * 65 + kq + 8 + e]); }
    u16* d = t.dst + (size_t)(n0 + nl) * t.K + kk0 + kq;
    *(bf16x8*)d = o0; *(bf16x8*)(d + 8) = o1;
  }
  __syncthreads();
}

__device__ __forceinline__ void prep_mod(const Params& p, int item, float* sm) {
  int i = item / 96, cc = item % 96;
  float* sc = sm;
  float* red = sm + 9 * 1024;
  int tid = vtid();
  for (int e = tid; e < 9 * 1024; e += 256) {
    int r = e >> 10, k = e & 1023;
    float v = (r < 8) ? p.in[1][r * 1024 + k] : p.in[3][k];
    sc[e] = siluf_(v);
  }
  __syncthreads();
  int kq = tid >> 6, col = tid & 63;
  int n = cc * 64 + col;
  float acc[9];
#pragma unroll
  for (int r = 0; r < 9; ++r) acc[r] = 0.f;
  const float* w = p.in[4] + (size_t)i * 1024 * 6144 + n;
  for (int k = kq * 256; k < kq * 256 + 256; ++k) {
    float wv = __builtin_nontemporal_load(w + (size_t)k * 6144);
#pragma unroll
    for (int r = 0; r < 9; ++r) acc[r] += sc[r * 1024 + k] * wv;
  }
#pragma unroll
  for (int r = 0; r < 9; ++r) red[(kq * 9 + r) * 64 + col] = acc[r];
  __syncthreads();
  for (int e = tid; e < 9 * 64; e += 256) {
    int r = e >> 6, c = e & 63;
    float s = red[(0 * 9 + r) * 64 + c] + red[(1 * 9 + r) * 64 + c] + red[(2 * 9 + r) * 64 + c] + red[(3 * 9 + r) * 64 + c];
    int nn = cc * 64 + c;
    p.mod[(size_t)(i * 9 + r) * 6144 + nn] = s + p.in[5][i * 6144 + nn];
  }
  __syncthreads();
}

__device__ __forceinline__ void prep_copy(const Params& p, int item) {
  int tid = vtid();
#pragma unroll 4
  for (int i = 0; i < 16; ++i) {
    int row = item * 16 + i;
    int b = row / PB, pp = row - b * PB;
    const float* src = (pp < CTX) ? (p.in[2] + ((size_t)b * CTX + pp) * D_) : (p.in[0] + ((size_t)b * SEQ + (pp - CTX)) * D_);
    float4 v = *(const float4*)(src + tid * 4);
    *(float4*)(p.X + (size_t)row * D_ + tid * 4) = v;
  }
}

__device__ __forceinline__ void prep_small(const Params& p, int item) {
  int tid = vtid();
  if (item == 0) {
    for (int e = tid; e < 512; e += 256) {
      int pos = e >> 3, j = e & 7;
      float inv = powf(10000.f, -(float)j / 8.f);
      float ang = (float)pos * inv;
      p.cs[e * 2] = cosf(ang); p.cs[e * 2 + 1] = sinf(ang);
    }
    for (int c = tid; c < 1024; c += 256) {
      float x0 = p.in[25][c], x1 = p.in[25][1024 + c], x2 = p.in[25][2048 + c], x3 = p.in[25][3072 + c];
      float m = fmaxf(fmaxf(x0, x1), fmaxf(x2, x3));
      float e0 = expf(x0 - m), e1 = expf(x1 - m), e2 = expf(x2 - m), e3 = expf(x3 - m);
      p.lb2[c] = (e1 + e2) / (e0 + e1 + e2 + e3);
    }
  } else {
    int idx = (item - 1) * 256 + tid;
    int dg = idx >> 6;
    float lre = p.in[15][idx], lim = p.in[16][idx];
    float dt = expf(p.in[17][dg]);
    float ar = lre * dt, ai = lim * dt;
    float er = expf(ar);
    float lbr = er * cosf(ai), lbi = er * sinf(ai);
    p.lamb[idx * 2] = lbr; p.lamb[idx * 2 + 1] = lbi;
    float nr = lbr - 1.f, ni = lbi;
    float den = lre * lre + lim * lim;
    float qr = (nr * lre + ni * lim) / den, qi = (ni * lre - nr * lim) / den;
    for (int c = 0; c < 16; ++c) {
      float br = p.in[18][idx * 16 + c], bi = p.in[19][idx * 16 + c];
      p.bbar[(idx * 16 + c) * 2] = qr * br - qi * bi;
      p.bbar[(idx * 16 + c) * 2 + 1] = qr * bi + qi * br;
    }
  }
}

__device__ __forceinline__ void modnorm_phase(const Params& p, int layer, int set, const float* gsrc, int fixl) {
  int lane = tidx() & 63, wv = tidx() >> 6;
  const float* g = gsrc + layer * 1024;
  for (int row0 = (bidx() * 8 + wv) * 4; row0 < T_; row0 += gridDim.x * 32) {
    float4 v[4][4]; float ss[4];
#pragma unroll
    for (int rr = 0; rr < 4; ++rr) {
      const float* x = (layer == 0 && set == 0) ? in_row(p, row0 + rr) : (p.X + (size_t)(row0 + rr) * D_);
#pragma unroll
      for (int i = 0; i < 4; ++i) v[rr][i] = *(const float4*)(x + i * 256 + lane * 4);
    }
    if (fixl >= 0 && row0 >= 32768) {
      const float* gate = p.mod + (size_t)(fixl * 9 + brow_of(row0)) * 6144 + 5 * 1024;
#pragma unroll
      for (int i = 0; i < 4; ++i) {
        int c = i * 256 + lane * 4;
        float4 gt = *(const float4*)(gate + c);
#pragma unroll
        for (int rr = 0; rr < 4; ++rr) {
          float4 a = make_float4(0.f, 0.f, 0.f, 0.f);
#pragma unroll
          for (int q = 0; q < 8; ++q) {
            float4 t = *(const float4*)(p.part0 + ((size_t)q * 2048 + (row0 + rr - 32768)) * 1024 + c);
            a.x += t.x; a.y += t.y; a.z += t.z; a.w += t.w;
          }
          v[rr][i].x += gt.x * a.x; v[rr][i].y += gt.y * a.y; v[rr][i].z += gt.z * a.z; v[rr][i].w += gt.w * a.w;
          *(float4*)(p.X + (size_t)(row0 + rr) * D_ + c) = v[rr][i];
        }
      }
    }
#pragma unroll
    for (int rr = 0; rr < 4; ++rr) {
      float s = 0.f;
#pragma unroll
      for (int i = 0; i < 4; ++i) s += v[rr][i].x * v[rr][i].x + v[rr][i].y * v[rr][i].y + v[rr][i].z * v[rr][i].z + v[rr][i].w * v[rr][i].w;
      ss[rr] = rsqrtf(wave_sum(s) * (1.f / 1024.f) + EPS);
    }
    const float* md = p.mod + (size_t)(layer * 9 + brow_of(row0)) * 6144;
    const float* sh = md + (3 * set) * 1024; const float* sc = md + (3 * set + 1) * 1024;
#pragma unroll
    for (int i = 0; i < 4; ++i) {
      int c = i * 256 + lane * 4;
      float4 gg = *(const float4*)(g + c), s1 = *(const float4*)(sc + c), s0 = *(const float4*)(sh + c);
      gg.x *= (1.f + s1.x); gg.y *= (1.f + s1.y); gg.z *= (1.f + s1.z); gg.w *= (1.f + s1.w);
#pragma unroll
      for (int rr = 0; rr < 4; ++rr) {
        float rstd = ss[rr];
        bf16x4 o;
        o[0] = (short)f2bf(v[rr][i].x * rstd * gg.x + s0.x);
        o[1] = (short)f2bf(v[rr][i].y * rstd * gg.y + s0.y);
        o[2] = (short)f2bf(v[rr][i].z * rstd * gg.z + s0.z);
        o[3] = (short)f2bf(v[rr][i].w * rstd * gg.w + s0.w);
        *(bf16x4*)(p.U + (size_t)(row0 + rr) * D_ + c) = o;
      }
    }
  }
}

__device__ __forceinline__ void final_norm_phase(const Params& p, bool fix) {
  int lane = tidx() & 63, wv = tidx() >> 6;
  const float* g = p.in[35];
  for (int r = bidx() * 8 + wv; r < NB * SEQ; r += gridDim.x * 8) {
    int b = r / SEQ, t = r - b * SEQ;
    const int grow = b * PB + CTX + t;
    const float* x = p.X + (size_t)grow * D_;
    float4 v[4]; float ss = 0.f;
#pragma unroll
    for (int i = 0; i < 4; ++i) v[i] = *(const float4*)(x + i * 256 + lane * 4);
    if (fix && grow >= 32768) {
      const float* gate = p.mod + (size_t)(3 * 9 + b) * 6144 + 5 * 1024;
#pragma unroll
      for (int i = 0; i < 4; ++i) {
        int c = i * 256 + lane * 4;
        float4 gt = *(const float4*)(gate + c);
        float4 a = make_float4(0.f, 0.f, 0.f, 0.f);
#pragma unroll
        for (int q = 0; q < 8; ++q) {
          float4 tq = *(const float4*)(p.part3 + ((size_t)q * 2048 + (grow - 32768)) * 1024 + c);
          a.x += tq.x; a.y += tq.y; a.z += tq.z; a.w += tq.w;
        }
        v[i].x += gt.x * a.x; v[i].y += gt.y * a.y; v[i].z += gt.z * a.z; v[i].w += gt.w * a.w;
      }
    }
#pragma unroll
    for (int i = 0; i < 4; ++i) ss += v[i].x * v[i].x + v[i].y * v[i].y + v[i].z * v[i].z + v[i].w * v[i].w;
    ss = wave_sum(ss);
    float rstd = rsqrtf(ss * (1.f / 1024.f) + EPS);
#pragma unroll
    for (int i = 0; i < 4; ++i) {
      int c = i * 256 + lane * 4;
      float4 gg = *(const float4*)(g + c);
      float4 o = make_float4(v[i].x * rstd * gg.x, v[i].y * rstd * gg.y, v[i].z * rstd * gg.z, v[i].w * rstd * gg.w);
      { f32x4 o4 = {o.x, o.y, o.z, o.w}; __builtin_nontemporal_store(o4, (f32x4*)(p.out + (size_t)r * D_ + c)); }
    }
  }
}

struct GA {
  const u16* A; const u16* Bt; int lda, K; int row0, arb, mt, nt; int mode; int layer, set;
  void* o0; void* o1; int ldo, orb; float scale;
  int kb, ke;
};
enum { E_LAT = 0, E_BF16 = 1, E_KV = 2, E_RES = 3, E_F32 = 4, E_GLU = 5, E_HG = 6, E_FFNUP = 7, E_PART = 8 };

constexpr int GLD = 72;

__device__ __forceinline__ void gemm_tile(const Params& p, const GA& g, int tm, int tn, u16* smem) {
  const int tid = tidx(), lane = tid & 63, wv = tid >> 6;
  const int wm = wv >> 2, wn = wv & 3;
  const int l15 = lane & 15, lg = lane >> 4;
  int m0 = g.row0 + tm * 256; const int n0 = tn * 256;
  int frow0 = 0;
  if (g.mode == E_FFNUP) { frow0 = 254 * tm - 1; m0 = 0; }
  unsigned char* sm8 = (unsigned char*)smem;
  const u16* Ag = g.A + (size_t)(m0 - g.arb) * g.lda;
  const u16* Bg = g.Bt + (size_t)n0 * g.K;
  f32x4 acc[8][4];
#pragma unroll
  for (int i = 0; i < 8; ++i)
#pragma unroll
    for (int j = 0; j < 4; ++j) acc[i][j] = (f32x4){0.f, 0.f, 0.f, 0.f};
  const int nk = g.K >> 6;
  auto glds_piece = [&](int kt, int buf, int i) {
    int q = wv * 4 + i;
    int r = 8 * q + (lane >> 3);
    int csrc = (lane & 7) ^ ((r >> 1) & 7);
    int ar = r;
    if (g.mode == E_FFNUP) ar = min(max(frow0 + r, 0), T_ - 1);
    const u16* ga = Ag + (size_t)ar * g.lda + kt * 64 + csrc * 8;
    const u16* gb = Bg + (size_t)r * g.K + kt * 64 + csrc * 8;
    unsigned char* la = sm8 + buf * 65536 + q * 1024 + lane * 16;
    __builtin_amdgcn_global_load_lds((const unsigned*)ga, (__attribute__((address_space(3))) unsigned*)la, 16, 0, 0);
    __builtin_amdgcn_global_load_lds((const unsigned*)gb, (__attribute__((address_space(3))) unsigned*)(la + 32768), 16, 0, 0);
  };
  const int kb = g.kb, ke = (g.ke > 0) ? g.ke : nk;
#pragma unroll
  for (int i = 0; i < 4; ++i) glds_piece(kb, 0, i);
  asm volatile("s_waitcnt vmcnt(0)" ::: "memory");
  __syncthreads();
  { const int k1 = (kb + 1 < ke) ? kb + 1 : kb; glds_piece(k1, 1, 0); glds_piece(k1, 1, 1); }
  const int sw = l15 >> 1;
  bf16x8 cb[4], ca[2];
  {
    const unsigned char* pa = sm8 + (wm * 128 + l15) * 128;
    const unsigned char* pb = sm8 + 32768 + (wn * 64 + l15) * 128;
    const int co = ((0 * 4 + lg) ^ sw) << 4;
#pragma unroll
    for (int j = 0; j < 4; ++j) cb[j] = *(const bf16x8*)(pb + j * 2048 + co);
    ca[0] = *(const bf16x8*)(pa + co); ca[1] = *(const bf16x8*)(pa + 2048 + co);
  }
  for (int kt = kb; kt < ke; ++kt) {
    const int buf = (kt - kb) & 1;
    const int ktn = (kt + 1 < ke) ? kt + 1 : kt;
    const unsigned char* pa = sm8 + buf * 65536 + (wm * 128 + l15) * 128;
    const unsigned char* pb = sm8 + buf * 65536 + 32768 + (wn * 64 + l15) * 128;
    const unsigned char* pan = sm8 + (buf ^ 1) * 65536 + (wm * 128 + l15) * 128;
    const unsigned char* pbn = sm8 + (buf ^ 1) * 65536 + 32768 + (wn * 64 + l15) * 128;
#pragma unroll
    for (int s = 0; s < 8; ++s) {
      const int ks = s >> 2, pp = s & 3;
      bf16x8 nb[4], na[2];
      if (s < 2) glds_piece(ktn, buf ^ 1, s + 2);
      if (s < 7) {
        const int ks2 = (s + 1) >> 2, p2 = (s + 1) & 3;
        const int co = ((ks2 * 4 + lg) ^ sw) << 4;
        if (p2 == 0) {
#pragma unroll
          for (int j = 0; j < 4; ++j) nb[j] = *(const bf16x8*)(pb + j * 2048 + co);
        }
        na[0] = *(const bf16x8*)(pa + (2 * p2) * 2048 + co);
        na[1] = *(const bf16x8*)(pa + (2 * p2 + 1) * 2048 + co);
      } else {
        asm volatile("s_waitcnt vmcnt(0)" ::: "memory");
        __syncthreads();
        { const int k2 = (kt + 2 < ke) ? kt + 2 : ke - 1; glds_piece(k2, buf, 0); glds_piece(k2, buf, 1); }
        const int co = ((0 * 4 + lg) ^ sw) << 4;
#pragma unroll
        for (int j = 0; j < 4; ++j) nb[j] = *(const bf16x8*)(pbn + j * 2048 + co);
        na[0] = *(const bf16x8*)(pan + co);
        na[1] = *(const bf16x8*)(pan + 2048 + co);
      }
#pragma unroll
      for (int ii = 0; ii < 2; ++ii)
#pragma unroll
        for (int j = 0; j < 4; ++j)
          acc[2 * pp + ii][j] = __builtin_amdgcn_mfma_f32_16x16x32_bf16(cb[j], ca[ii], acc[2 * pp + ii][j], 0, 0, 0);
      ca[0] = na[0]; ca[1] = na[1];
      if (s == 3 || s == 7) {
#pragma unroll
        for (int j = 0; j < 4; ++j) cb[j] = nb[j];
      }
      if (s & 1) __builtin_amdgcn_sched_barrier(0);
    }
  }
  asm volatile("s_waitcnt vmcnt(0)" ::: "memory");
  __syncthreads();
  if (g.mode == E_FFNUP) {
    u16* sT = smem;
#pragma unroll
    for (int i = 0; i < 8; ++i) {
      int lr = wm * 128 + 16 * i + l15;
#pragma unroll
      for (int j = 0; j < 4; ++j) {
        int cl = ((j >= 2) ? 128 : 0) + 32 * wn + 16 * (j & 1) + 4 * lg;
        f32x4 v = acc[i][j];
        bf16x4 o; o[0] = (short)f2bf(v[0]); o[1] = (short)f2bf(v[1]); o[2] = (short)f2bf(v[2]); o[3] = (short)f2bf(v[3]);
        *(bf16x4*)(sT + lr * 264 + cl) = o;
      }
    }
    __syncthreads();
    {
      const float* cw = p.in[32] + (size_t)g.layer * 3 * F2;
      const float* cb = p.in[33] + (size_t)g.layer * F2;
      const int f4 = (tid & 31) * 4;
      const int fg = tn * 128 + f4;
      float4 wa0 = *(const float4*)(cw + fg), wa1 = *(const float4*)(cw + F2 + fg), wa2 = *(const float4*)(cw + 2 * F2 + fg);
      float4 wg0 = *(const float4*)(cw + F_ + fg), wg1 = *(const float4*)(cw + F2 + F_ + fg), wg2 = *(const float4*)(cw + 2 * F2 + F_ + fg);
      float4 ba = *(const float4*)(cb + fg), bg = *(const float4*)(cb + F_ + fg);
#pragma unroll 4
      for (int it = 0; it < 16; ++it) {
        int lr = 1 + (tid >> 5) + 16 * it;
        int row = frow0 + lr;
        if (lr <= 254 && row < T_) {
          int pp = row % PB;
          bool hasp = (pp != 0) && (pp != CTX);
          bool hasn = (pp != CTX - 1) && (pp != PB - 1);
          float mp = hasp ? 1.f : 0.f, mn = hasn ? 1.f : 0.f;
          bf16x4 a0 = *(const bf16x4*)(sT + (lr - 1) * 264 + f4), a1 = *(const bf16x4*)(sT + lr * 264 + f4), a2 = *(const bf16x4*)(sT + (lr + 1) * 264 + f4);
          bf16x4 g0 = *(const bf16x4*)(sT + (lr - 1) * 264 + 128 + f4), g1 = *(const bf16x4*)(sT + lr * 264 + 128 + f4), g2 = *(const bf16x4*)(sT + (lr + 1) * 264 + 128 + f4);
          float w0[4] = {wa0.x, wa0.y, wa0.z, wa0.w}, w1[4] = {wa1.x, wa1.y, wa1.z, wa1.w}, w2[4] = {wa2.x, wa2.y, wa2.z, wa2.w};
          float v0[4] = {wg0.x, wg0.y, wg0.z, wg0.w}, v1[4] = {wg1.x, wg1.y, wg1.z, wg1.w}, v2[4] = {wg2.x, wg2.y, wg2.z, wg2.w};
          float bb[4] = {ba.x, ba.y, ba.z, ba.w}, bgv[4] = {bg.x, bg.y, bg.z, bg.w};
          bf16x4 o;
#pragma unroll
          for (int e = 0; e < 4; ++e) {
            float av = bf2f((u16)a1[e]) * w1[e] + bb[e] + mp * bf2f((u16)a0[e]) * w0[e] + mn * bf2f((u16)a2[e]) * w2[e];
            float gv = bf2f((u16)g1[e]) * v1[e] + bgv[e] + mp * bf2f((u16)g0[e]) * v0[e] + mn * bf2f((u16)g2[e]) * v2[e];
            o[e] = (short)f2bf(av * siluf_(gv));
          }
          *(bf16x4*)(p.act + (size_t)row * F_ + fg) = o;
        }
      }
    }
    __syncthreads();
    return;
  }
#define EPI_LOOP(...) \
  _Pragma("unroll") for (int i = 0; i < 8; ++i) { \
    const int row = m0 + wm * 128 + 16 * i + l15; \
    _Pragma("unroll") for (int j = 0; j < 4; ++j) { \
      const int col = n0 + wn * 64 + 16 * j + 4 * lg; \
      f32x4 v = acc[i][j]; \
      __VA_ARGS__ \
      asm volatile("" ::: "memory"); \
    } }
  switch (g.mode) {
    case E_GLU: {
      float4 gtg[2];
      {
        const float* gate = p.mod + (size_t)(g.layer * 9 + brow_of(m0)) * 6144 + (3 * g.set + 2) * 1024;
#pragma unroll
        for (int j = 0; j < 2; ++j) {
          float4 c = *(const float4*)(gate + tn * 128 + 32 * wn + 16 * j + 4 * lg);
          gtg[j] = make_float4(c.x * g.scale, c.y * g.scale, c.z * g.scale, c.w * g.scale);
        }
      }
#pragma unroll
      for (int i4 = 0; i4 < 8; i4 += 2) {
        float4 xv[2][2];
#pragma unroll
        for (int ii = 0; ii < 2; ++ii) {
          const int row = m0 + wm * 128 + 16 * (i4 + ii) + l15;
#pragma unroll
          for (int j = 0; j < 2; ++j) xv[ii][j] = *(const float4*)(p.X + (size_t)row * D_ + tn * 128 + 32 * wn + 16 * j + 4 * lg);
        }
#pragma unroll
        for (int ii = 0; ii < 2; ++ii) {
          const int row = m0 + wm * 128 + 16 * (i4 + ii) + l15;
#pragma unroll
          for (int j = 0; j < 2; ++j) {
            f32x4 a = acc[i4 + ii][j], gg = acc[i4 + ii][j + 2];
            float4 x = xv[ii][j], gt = gtg[j];
            x.x += gt.x * a[0] * sigmoidf_(gg[0]); x.y += gt.y * a[1] * sigmoidf_(gg[1]);
            x.z += gt.z * a[2] * sigmoidf_(gg[2]); x.w += gt.w * a[3] * sigmoidf_(gg[3]);
            *(float4*)(p.X + (size_t)row * D_ + tn * 128 + 32 * wn + 16 * j + 4 * lg) = x;
          }
        }
        asm volatile("" ::: "memory");
      }
    } break;
    case E_LAT: {
      EPI_LOOP(if (col < 672) *(float4*)((float*)g.o0 + (size_t)row * 672 + col) = make_float4(v[0], v[1], v[2], v[3]);)
    } break;
    case E_PART: {
      EPI_LOOP(*(float4*)((float*)g.o0 + (size_t)(row - g.orb) * 1024 + col) = make_float4(v[0], v[1], v[2], v[3]);)
    } break;
    case E_F32: {
      EPI_LOOP(*(float4*)((float*)g.o0 + (size_t)(row - g.orb) * g.ldo + col) = make_float4(v[0], v[1], v[2], v[3]);)
    } break;
    case E_BF16: {
      EPI_LOOP(bf16x4 o; o[0] = (short)f2bf(v[0]); o[1] = (short)f2bf(v[1]); o[2] = (short)f2bf(v[2]); o[3] = (short)f2bf(v[3]);
               *(bf16x4*)((u16*)g.o0 + (size_t)(row - g.orb) * g.ldo + col) = o;)
    } break;
    case E_KV: {
      EPI_LOOP(int head = col >> 7; int w = col & 127;
               bf16x4 o; o[0] = (short)f2bf(v[0]); o[1] = (short)f2bf(v[1]); o[2] = (short)f2bf(v[2]); o[3] = (short)f2bf(v[3]);
               u16* dst = (w < 64) ? ((u16*)g.o0 + (size_t)row * 1024 + head * 64 + w) : ((u16*)g.o1 + (size_t)row * 1024 + head * 64 + (w - 64));
               *(bf16x4*)dst = o;)
    } break;
    case E_RES: {
      float4 gtr[4];
      {
        const float* gate = p.mod + (size_t)(g.layer * 9 + brow_of(m0)) * 6144 + (3 * g.set + 2) * 1024;
#pragma unroll
        for (int j = 0; j < 4; ++j) {
          float4 c = *(const float4*)(gate + n0 + wn * 64 + 16 * j + 4 * lg);
          gtr[j] = make_float4(c.x * g.scale, c.y * g.scale, c.z * g.scale, c.w * g.scale);
        }
      }
      const bool first = (g.layer == 0 && g.set == 0);
#pragma unroll
      for (int i2 = 0; i2 < 8; i2 += 2) {
        float4 xv[2][4];
#pragma unroll
        for (int ii = 0; ii < 2; ++ii) {
          const int row = m0 + wm * 128 + 16 * (i2 + ii) + l15;
          const float* xr = first ? in_row(p, row) : (p.X + (size_t)row * D_);
#pragma unroll
          for (int j = 0; j < 4; ++j) {
            const float* xa = xr + n0 + wn * 64 + 16 * j + 4 * lg;
            if (first) { f32x4 t4 = __builtin_nontemporal_load((const f32x4*)xa); xv[ii][j] = make_float4(t4[0], t4[1], t4[2], t4[3]); }
            else xv[ii][j] = *(const float4*)xa;
          }
        }
#pragma unroll
        for (int ii = 0; ii < 2; ++ii) {
          const int row = m0 + wm * 128 + 16 * (i2 + ii) + l15;
#pragma unroll
          for (int j = 0; j < 4; ++j) {
            f32x4 v = acc[i2 + ii][j];
            float4 x = xv[ii][j], gt = gtr[j];
            x.x += gt.x * v[0]; x.y += gt.y * v[1]; x.z += gt.z * v[2]; x.w += gt.w * v[3];
            *(float4*)(p.X + (size_t)row * D_ + n0 + wn * 64 + 16 * j + 4 * lg) = x;
          }
        }
        asm volatile("" ::: "memory");
      }
    } break;
    case E_HG: {
      float4 lbh[4];
#pragma unroll
      for (int j = 0; j < 4; ++j) lbh[j] = *(const float4*)(p.lb2 + ((n0 + wn * 64 + 16 * j + 4 * lg) & 1023));
      EPI_LOOP(int part = col >> 10; int c = col & 1023;
               size_t rl = (size_t)(row - g.orb);
               bf16x4 o;
               if (part == 0) {
                 _Pragma("unroll") for (int e = 0; e < 4; ++e) o[e] = (short)f2bf(siluf_(v[e]) * 0.08838834764831845f);
                 *(bf16x4*)(p.hq + rl * 1024 + c) = o;
               } else if (part <= 2) {
                 float4 lb = lbh[j];
                 float lbv[4] = {lb.x, lb.y, lb.z, lb.w};
                 _Pragma("unroll") for (int e = 0; e < 4; ++e) { float f = lbv[e] + (1.f - lbv[e]) * sigmoidf_(v[e]); o[e] = (short)__half_as_ushort(__float2half(__logf(f))); }
                 *(bf16x4*)(p.hlf + (size_t)(part - 1) * HR * 1024 + rl * 1024 + c) = o;
               } else if (part == 3) {
                 _Pragma("unroll") for (int e = 0; e < 4; ++e) o[e] = (short)f2bf(v[e]);
                 *(bf16x4*)(p.hv + rl * 1024 + c) = o;
               } else {
                 _Pragma("unroll") for (int e = 0; e < 4; ++e) o[e] = (short)f2bf(siluf_(v[e]));
                 *(bf16x4*)(p.hsg + rl * 1024 + c) = o;
               })
    } break;
    default: break;
  }
#undef EPI_LOOP
}

__device__ __forceinline__ void latnorm_phase(const Params& p) {
  int lane = tidx() & 63, wv = tidx() >> 6;
  const float* gq = p.in[9]; const float* gkv = p.in[11];
  for (int row = bidx() * 8 + wv; row < T_; row += gridDim.x * 8) {
    const float* l = p.lat + (size_t)row * 672;
    float q[6]; float ss = 0.f;
#pragma unroll
    for (int i = 0; i < 6; ++i) { q[i] = l[i * 64 + lane]; ss += q[i] * q[i]; }
    ss = wave_sum(ss);
    float rq = rsqrtf(ss * (1.f / 384.f) + EPS);
#pragma unroll
    for (int i = 0; i < 6; ++i) p.qn[(size_t)row * 384 + i * 64 + lane] = f2bf(q[i] * rq * gq[i * 64 + lane]);
    float k[4]; ss = 0.f;
#pragma unroll
    for (int i = 0; i < 4; ++i) { k[i] = l[384 + i * 64 + lane]; ss += k[i] * k[i]; }
    ss = wave_sum(ss);
    float rk = rsqrtf(ss * (1.f / 256.f) + EPS);
#pragma unroll
    for (int i = 0; i < 4; ++i) p.kvn[(size_t)row * 256 + i * 64 + lane] = f2bf(k[i] * rk * gkv[i * 64 + lane]);
    int b = row / PB, pp = row - b * PB;
    float v = (lane < 32) ? l[640 + lane] : 0.f;
    int jj = lane & 15;
    float vp = __shfl_xor(v, 8);
    float o = v;
    if (pp >= CTX) {
      int t = pp - CTX;
      int sec = (lane >> 4) & 1;
      int pos = sec == 0 ? (t >> 6) : (t & 63);
      int j = jj & 7;
      float c = p.cs[(pos * 8 + j) * 2], s = p.cs[(pos * 8 + j) * 2 + 1];
      o = (jj < 8) ? (v * c - vp * s) : (vp * s + v * c);
    }
    if (lane < 32) p.kr[(size_t)row * 32 + lane] = f2bf(o);
  }
}

template <int DK, int U, int MODE, int NW, int SUB>
__device__ __forceinline__ void attn_item(const Params& p, int item, u16* smem) {
  constexpr int NT = 64 * NW, KT = 64 * SUB;
  constexpr int KLD = DK + 8, VLD = 72, KS = DK / 32;
  const int tid = (NW == 8) ? tidx() : vtid(), lane = tid & 63, wv = tid >> 6;
  const int l15 = lane & 15, lg = lane >> 4;
  u16* sK = smem;
  u16* sV = smem + 2 * KT * KLD;
  float* sBias = (float*)(smem + 2 * KT * KLD + 2 * KT * VLD);
  int b, h, qrow0, nt, r = 0, r0 = 0, rq = 0, r0q = 0;
  constexpr int NLOC = (MODE == 2 && U == 2) ? 9 : 8;
  if (MODE == 0 && NW == 8) { int qb = item & 15; h = (item >> 4) & 15; b = item >> 8; qrow0 = b * PB + CTX + qb * 256 + wv * 32; nt = 68 / SUB; }
  else if (MODE == 1 && NW == 8) { h = item & 15; b = item >> 4; qrow0 = b * PB + wv * 32; nt = 4 / SUB; }
  else if (MODE == 0) { int qb = item & 31; h = (item >> 5) & 15; b = item >> 9; qrow0 = b * PB + CTX + qb * 128 + wv * 32; nt = 68; }
  else if (MODE == 1) { int qb = item & 1; h = (item >> 1) & 15; b = item >> 5; qrow0 = b * PB + qb * 128 + wv * 32; nt = 4; }
  else if (MODE == 2 && U == 2) {
    r = 2 * (item & 31); h = (item >> 5) & 15; b = item >> 9;
    rq = r + (wv >> 1); qrow0 = b * PB + CTX + rq * 64 + (wv & 1) * 32; nt = 13;
    r0 = min(max(r - 4, 0), 56); r0q = min(max(rq - 4, 0), 56);
  }
  else if (MODE == 2) { r = item & 63; h = (item >> 6) & 15; b = item >> 10; qrow0 = b * PB + CTX + r * 64 + wv * 16; nt = 12; r0 = min(max(r - 4, 0), 56); rq = r; r0q = r0; }
  else { int qb = item & 3; h = (item >> 2) & 15; b = item >> 6; qrow0 = b * PB + qb * 64 + wv * 16; nt = 4; }
  const float cscale = (MODE <= 1 ? 0.10206207261596577f : 0.125f) * LOG2E;

  bf16x8 qf[U][KS];
#pragma unroll
  for (int u = 0; u < U; ++u) {
    int qrow = qrow0 + 16 * u + l15;
    const u16* qp = (MODE <= 1) ? (p.Qm + (size_t)qrow * 1536 + h * 96) : (p.QKV + (size_t)qrow * 3072 + h * 64);
#pragma unroll
    for (int ks = 0; ks < KS; ++ks) qf[u][ks] = *(const bf16x8*)(qp + ks * 32 + lg * 8);
    if (MODE == 0) {
      int t = qrow - b * PB - CTX;
      int sec = lg >> 1;
      int pos = sec == 0 ? (t >> 6) : (t & 63);
      bf16x8 o;
#pragma unroll
      for (int j = 0; j < 8; ++j) {
        float v = bf2f((u16)qf[u][2][j]);
        float vp = __shfl_xor(v, 16);
        float c = p.cs[(pos * 8 + j) * 2], s = p.cs[(pos * 8 + j) * 2 + 1];
        float ov = ((lg & 1) == 0) ? (v * c - vp * s) : (vp * s + v * c);
        o[j] = (short)f2bf(ov);
      }
      qf[u][2] = o;
    }
  }
  float mrun[U], lsum[U];
  f32x4 oacc[4][U];
#pragma unroll
  for (int u = 0; u < U; ++u) {
    mrun[u] = -1e30f; lsum[u] = 0.f;
#pragma unroll
    for (int d = 0; d < 4; ++d) oacc[d][u] = (f32x4){0.f, 0.f, 0.f, 0.f};
  }
  bf16x8 rk[2], rkr, rv[2];
  auto krow_of = [&](int kt) -> int {
    if (MODE == 0) return b * PB + kt * KT;
    if (MODE == 2) return kt < NLOC ? (b * PB + CTX + min(r0 + kt, 63) * 64) : (b * PB + (kt - NLOC) * 64);
    return b * PB + kt * KT;
  };
  auto gload = [&](int kt) {
    int kr0 = krow_of(kt);
#pragma unroll
    for (int i = 0; i < 2; ++i) {
      int id = tid + NT * i; int key = id >> 3, c = id & 7;
      if (MODE <= 1) {
        rk[i] = *(const bf16x8*)(p.Kn + (size_t)(kr0 + key) * 1024 + h * 64 + c * 8);
        rv[i] = *(const bf16x8*)(p.Vm + (size_t)(kr0 + key) * 1024 + h * 64 + c * 8);
      } else {
        rk[i] = *(const bf16x8*)(p.QKV + (size_t)(kr0 + key) * 3072 + 1024 + h * 64 + c * 8);
        rv[i] = *(const bf16x8*)(p.QKV + (size_t)(kr0 + key) * 3072 + 2048 + h * 64 + c * 8);
      }
    }
    if (MODE <= 1) { int key = tid >> 2, c = tid & 3; rkr = *(const bf16x8*)(p.kr + (size_t)(kr0 + key) * 32 + c * 8); }
  };
  auto lstore = [&](int buf) {
#pragma unroll
    for (int i = 0; i < 2; ++i) {
      int id = tid + NT * i; int key = id >> 3, c = id & 7;
      *(bf16x8*)(sK + (buf * KT + key) * KLD + c * 8) = rk[i];
      *(bf16x8*)(sV + (buf * KT + key) * VLD + c * 8) = rv[i];
    }
    if (MODE <= 1) { int key = tid >> 2, c = tid & 3; *(bf16x8*)(sK + (buf * KT + key) * KLD + 64 + c * 8) = rkr; }
  };
  gload(0); lstore(0);
  if (MODE == 2) { for (int e = tid; e < 465; e += NT) sBias[e] = p.in[29][h * 465 + e] * LOG2E; }
  __syncthreads();
  for (int kt = 0; kt < nt; ++kt) {
    const int buf = kt & 1;
    if (kt + 1 < nt) gload(kt + 1);
#pragma unroll
    for (int sub = 0; sub < SUB; ++sub) {
    f32x4 sacc[4][U];
#pragma unroll
    for (int ms = 0; ms < 4; ++ms)
#pragma unroll
      for (int u = 0; u < U; ++u) sacc[ms][u] = (f32x4){0.f, 0.f, 0.f, 0.f};
    const bool local_tile = (MODE == 2) && (kt < NLOC);
    if (MODE == 2 && local_tile && (unsigned)((r0 + kt) - r0q) >= 8u) continue;
    const int mlo = (MODE == 2 && U == 1 && local_tile) ? ((wv <= 1) ? 0 : wv - 1) : 0;
    const int mhi = (MODE == 2 && U == 1 && local_tile) ? ((wv >= 2) ? 3 : wv + 1) : 3;
    if (MODE <= 1) {
#pragma unroll
      for (int hf = 0; hf < 2; ++hf) {
        bf16x8 kf[2][KS];
#pragma unroll
        for (int m2 = 0; m2 < 2; ++m2)
#pragma unroll
          for (int ks = 0; ks < KS; ++ks)
            kf[m2][ks] = *(const bf16x8*)(sK + (buf * KT + sub * 64 + 16 * (2 * hf + m2) + l15) * KLD + ks * 32 + lg * 8);
        __builtin_amdgcn_sched_barrier(0);
        __builtin_amdgcn_s_setprio(1);
#pragma unroll
        for (int m2 = 0; m2 < 2; ++m2)
#pragma unroll
          for (int ks = 0; ks < KS; ++ks)
#pragma unroll
            for (int u = 0; u < U; ++u)
              sacc[2 * hf + m2][u] = __builtin_amdgcn_mfma_f32_16x16x32_bf16(kf[m2][ks], qf[u][ks], sacc[2 * hf + m2][u], 0, 0, 0);
        __builtin_amdgcn_s_setprio(0);
        __builtin_amdgcn_sched_barrier(0);
      }
    } else {
      bf16x8 kf[4][KS];
#pragma unroll
      for (int ms = 0; ms < 4; ++ms)
#pragma unroll
        for (int ks = 0; ks < KS; ++ks)
          kf[ms][ks] = *(const bf16x8*)(sK + (buf * KT + sub * 64 + 16 * ms + l15) * KLD + ks * 32 + lg * 8);
      __builtin_amdgcn_sched_barrier(0);
#pragma unroll
      for (int ms = 0; ms < 4; ++ms) {
        if (MODE == 2 && (ms < mlo || ms > mhi)) continue;
#pragma unroll
        for (int ks = 0; ks < KS; ++ks)
#pragma unroll
          for (int u = 0; u < U; ++u) sacc[ms][u] = __builtin_amdgcn_mfma_f32_16x16x32_bf16(kf[ms][ks], qf[u][ks], sacc[ms][u], 0, 0, 0);
      }
      __builtin_amdgcn_sched_barrier(0);
    }
    bf16x8 pf[U][2];
#pragma unroll
    for (int u = 0; u < U; ++u) {
      const float* brow = nullptr; int dlt = 0;
      if (MODE == 2) {
        int w = (U == 2) ? ((wv & 1) * 32 + 16 * u + l15) : (wv * 16 + l15);
        int cs0 = min(max(w - 8, 0), 48);
        dlt = 4 * lg - cs0;
        brow = sBias + ((r0 + kt) - rq + 7) * 31 + (4 * lg - w + 15);
      }
      float tmax = -1e30f;
      if (local_tile) {
#pragma unroll
        for (int ms = 0; ms < 4; ++ms) {
          if (ms < mlo || ms > mhi) continue;
#pragma unroll
          for (int rr = 0; rr < 4; ++rr) {
            bool ok = (unsigned)(16 * ms + rr + dlt) < 16u;
            float tv = ok ? __builtin_fmaf(sacc[ms][u][rr], cscale, brow[16 * ms + rr]) : -1e30f;
            sacc[ms][u][rr] = tv;
            tmax = vmax(tmax, tv);
          }
        }
      } else {
#pragma unroll
        for (int ms = 0; ms < 4; ++ms) {
          tmax = vmax3(tmax, sacc[ms][u][0], sacc[ms][u][1]);
          tmax = vmax3(tmax, sacc[ms][u][2], sacc[ms][u][3]);
        }
        tmax *= cscale;
      }
      tmax = vmax(tmax, __shfl_xor(tmax, 16));
      tmax = vmax(tmax, __shfl_xor(tmax, 32));
      if (__any(tmax > mrun[u] + 8.f)) {
        float mnew = vmax(mrun[u], tmax);
        float alpha = __builtin_amdgcn_exp2f(mrun[u] - mnew);
        mrun[u] = mnew;
        lsum[u] *= alpha;
#pragma unroll
        for (int d = 0; d < 4; ++d) { oacc[d][u][0] *= alpha; oacc[d][u][1] *= alpha; oacc[d][u][2] *= alpha; oacc[d][u][3] *= alpha; }
      }
      const float mr = mrun[u];
      float ps = 0.f;
      u32x4 pk[2];
#pragma unroll
      for (int ms = 0; ms < 4; ++ms) {
        if (MODE == 2 && (ms < mlo || ms > mhi)) { pk[ms >> 1][(ms & 1) * 2] = 0u; pk[ms >> 1][(ms & 1) * 2 + 1] = 0u; continue; }
        float pv[4];
#pragma unroll
        for (int rr = 0; rr < 4; ++rr) {
          float x = local_tile ? (sacc[ms][u][rr] - mr) : __builtin_fmaf(sacc[ms][u][rr], cscale, -mr);
          pv[rr] = __builtin_amdgcn_exp2f(x);
          ps += pv[rr];
        }
        pk[ms >> 1][(ms & 1) * 2] = pack_bf16(pv[0], pv[1]);
        pk[ms >> 1][(ms & 1) * 2 + 1] = pack_bf16(pv[2], pv[3]);
      }
      lsum[u] += ps;
      pf[u][0] = __builtin_bit_cast(bf16x8, pk[0]);
      pf[u][1] = __builtin_bit_cast(bf16x8, pk[1]);
    }
    if (MODE <= 1) {
#pragma unroll
      for (int hf = 0; hf < 2; ++hf) {
        bf16x8 vf[2][2];
#pragma unroll
        for (int d2 = 0; d2 < 2; ++d2)
#pragma unroll
          for (int kb = 0; kb < 2; ++kb) {
            const u16* vp = sV + (buf * KT + sub * 64 + 32 * kb + 4 * lg + (l15 >> 2)) * VLD + 16 * (2 * hf + d2) + 4 * (l15 & 3);
            bf16x4 a0 = __builtin_amdgcn_ds_read_tr16_b64_v4i16((__attribute__((address_space(3))) bf16x4*)vp);
            bf16x4 a1 = __builtin_amdgcn_ds_read_tr16_b64_v4i16((__attribute__((address_space(3))) bf16x4*)(vp + 16 * VLD));
            bf16x8 a;
            a[0] = a0[0]; a[1] = a0[1]; a[2] = a0[2]; a[3] = a0[3]; a[4] = a1[0]; a[5] = a1[1]; a[6] = a1[2]; a[7] = a1[3];
            vf[d2][kb] = a;
          }
        __builtin_amdgcn_sched_barrier(0);
        __builtin_amdgcn_s_setprio(1);
#pragma unroll
        for (int d2 = 0; d2 < 2; ++d2)
#pragma unroll
          for (int kb = 0; kb < 2; ++kb)
#pragma unroll
            for (int u = 0; u < U; ++u)
              oacc[2 * hf + d2][u] = __builtin_amdgcn_mfma_f32_16x16x32_bf16(vf[d2][kb], pf[u][kb], oacc[2 * hf + d2][u], 0, 0, 0);
        __builtin_amdgcn_s_setprio(0);
        __builtin_amdgcn_sched_barrier(0);
      }
    } else {
#pragma unroll
      for (int hf = 0; hf < 2; ++hf) {
        bf16x8 vf[2][2];
#pragma unroll
        for (int d2 = 0; d2 < 2; ++d2)
#pragma unroll
          for (int kb = 0; kb < 2; ++kb) {
            const u16* vp = sV + (buf * KT + sub * 64 + 32 * kb + 4 * lg + (l15 >> 2)) * VLD + 16 * (2 * hf + d2) + 4 * (l15 & 3);
            bf16x4 a0 = __builtin_amdgcn_ds_read_tr16_b64_v4i16((__attribute__((address_space(3))) bf16x4*)vp);
            bf16x4 a1 = __builtin_amdgcn_ds_read_tr16_b64_v4i16((__attribute__((address_space(3))) bf16x4*)(vp + 16 * VLD));
            bf16x8 a;
            a[0] = a0[0]; a[1] = a0[1]; a[2] = a0[2]; a[3] = a0[3]; a[4] = a1[0]; a[5] = a1[1]; a[6] = a1[2]; a[7] = a1[3];
            vf[d2][kb] = a;
          }
        __builtin_amdgcn_sched_barrier(0);
#pragma unroll
        for (int d2 = 0; d2 < 2; ++d2)
#pragma unroll
          for (int kb = 0; kb < 2; ++kb) {
            if (MODE == 2 && (2 * kb + 1 < mlo || 2 * kb > mhi)) continue;
#pragma unroll
            for (int u = 0; u < U; ++u)
              oacc[2 * hf + d2][u] = __builtin_amdgcn_mfma_f32_16x16x32_bf16(vf[d2][kb], pf[u][kb], oacc[2 * hf + d2][u], 0, 0, 0);
          }
        __builtin_amdgcn_sched_barrier(0);
      }
    }
    }
    if (kt + 1 < nt) lstore(buf ^ 1);
    __syncthreads();
  }
#pragma unroll
  for (int u = 0; u < U; ++u) {
    float l = lsum[u];
    l += __shfl_xor(l, 16); l += __shfl_xor(l, 32);
    float inv = 1.f / l;
    int qrow = qrow0 + 16 * u + l15;
#pragma unroll
    for (int d = 0; d < 4; ++d) {
      bf16x4 o;
#pragma unroll
      for (int e = 0; e < 4; ++e) o[e] = (short)f2bf(oacc[d][u][e] * inv);
      *(bf16x4*)(p.U + (size_t)qrow * D_ + h * 64 + 16 * d + 4 * lg) = o;
    }
  }
}

template <bool EMIT>
__device__ __forceinline__ void s5_scan_item(const Params& p, int item, float* smem) {
  const int tid = vtid(), lane = tid & 63, wv = tid >> 6;
  float* hs = smem + wv * 4640;
  float* Cs = hs + 2080;
  float* zs = Cs + 2304;
  int wi = item * 4 + wv;
  int c = wi % 68; int g = (wi / 68) & 31; int d = (wi / (68 * 32)) & 1; int b = wi / (68 * 64);
  int dg = d * 32 + g;
  int n = lane;
  float lr = p.lamb[(dg * 64 + n) * 2], li = p.lamb[(dg * 64 + n) * 2 + 1];
  float bbr[16], bbi[16];
#pragma unroll
  for (int cc = 0; cc < 16; ++cc) { bbr[cc] = p.bbar[((dg * 64 + n) * 16 + cc) * 2]; bbi[cc] = p.bbar[((dg * 64 + n) * 16 + cc) * 2 + 1]; }
  float hr = 0.f, hi = 0.f;
  u16* hsb = (u16*)hs;
  bf16x8 cfr[4];
  if (EMIT) {
    hr = p.chst[((size_t)wi * 64 + n) * 2]; hi = p.chst[((size_t)wi * 64 + n) * 2 + 1];
    const int ch = lane & 15, lg4 = lane >> 4;
#pragma unroll
    for (int ks = 0; ks < 4; ++ks) {
      float4 cr = *(const float4*)(p.in[20] + (dg * 16 + ch) * 64 + 16 * ks + 4 * lg4);
      float4 ci = *(const float4*)(p.in[21] + (dg * 16 + ch) * 64 + 16 * ks + 4 * lg4);
      u32x4 pk;
      pk[0] = pack_bf16(cr.x, -ci.x); pk[1] = pack_bf16(cr.y, -ci.y); pk[2] = pack_bf16(cr.z, -ci.z); pk[3] = pack_bf16(cr.w, -ci.w);
      cfr[ks] = __builtin_bit_cast(bf16x8, pk);
    }
  }
  for (int sc = 0; sc < 4; ++sc) {
    {
      int st = lane >> 2, q4 = lane & 3;
      int row = b * PB + pos_of(d, c * 64 + sc * 16 + st);
      float4 zv = *(const float4*)(p.z + (size_t)row * 512 + g * 16 + q4 * 4);
      *(float4*)(zs + st * 16 + q4 * 4) = zv;
    }
    __syncthreads();
#pragma unroll 4
    for (int st = 0; st < 16; ++st) {
      float4 z0 = *(const float4*)(zs + st * 16), z1 = *(const float4*)(zs + st * 16 + 4);
      float4 z2 = *(const float4*)(zs + st * 16 + 8), z3 = *(const float4*)(zs + st * 16 + 12);
      float zz[16] = {z0.x, z0.y, z0.z, z0.w, z1.x, z1.y, z1.z, z1.w, z2.x, z2.y, z2.z, z2.w, z3.x, z3.y, z3.z, z3.w};
      float bur = 0.f, bui = 0.f;
#pragma unroll
      for (int cc = 0; cc < 16; ++cc) { bur += bbr[cc] * zz[cc]; bui += bbi[cc] * zz[cc]; }
      float nr = lr * hr - li * hi + bur;
      float ni = lr * hi + li * hr + bui;
      hr = nr; hi = ni;
      if (EMIT) { *(unsigned*)(hsb + st * 136 + 2 * n) = pack_bf16(hr, hi); }
    }
    __syncthreads();
    if (EMIT) {
      const int l15 = lane & 15, lg4 = lane >> 4;
      f32x4 ya = (f32x4){0.f, 0.f, 0.f, 0.f};
#pragma unroll
      for (int ks = 0; ks < 4; ++ks) {
        bf16x8 a = *(const bf16x8*)(hsb + l15 * 136 + 32 * ks + 8 * lg4);
        ya = __builtin_amdgcn_mfma_f32_16x16x32_bf16(a, cfr[ks], ya, 0, 0, 0);
      }
#pragma unroll
      for (int rr = 0; rr < 4; ++rr) {
        int row = b * PB + pos_of(d, c * 64 + sc * 16 + 4 * lg4 + rr);
        p.yd[((size_t)d * T_ + row) * 512 + g * 16 + l15] = ya[rr];
      }
      __syncthreads();
    }
  }
  if (!EMIT) { p.chst[((size_t)wi * 64 + n) * 2] = hr; p.chst[((size_t)wi * 64 + n) * 2 + 1] = hi; }
}

__device__ __forceinline__ void s5_combine_item(const Params& p, int item) {
  const int lane = tidx() & 63, wv = tidx() >> 6;
  int wi = item * 8 + wv;
  int g = wi & 31, d = (wi >> 5) & 1;
  int dg = d * 32 + g;
  float lr = p.lamb[(dg * 64 + lane) * 2], li = p.lamb[(dg * 64 + lane) * 2 + 1];
#pragma unroll
  for (int i = 0; i < 6; ++i) { float nr = lr * lr - li * li, ni = 2.f * lr * li; lr = nr; li = ni; }
  float Hr = 0.f, Hi = 0.f;
  for (int c = 0; c < 68; ++c) {
    size_t idx = (((size_t)wi * 68 + c) * 64 + lane) * 2;
    float a = p.chst[idx], bq = p.chst[idx + 1];
    p.chst[idx] = Hr; p.chst[idx + 1] = Hi;
    float nr = lr * Hr - li * Hi + a, ni = lr * Hi + li * Hr + bq;
    Hr = nr; Hi = ni;
  }
}

__device__ __forceinline__ void s5_gelu_phase(const Params& p) {
  const float* dsk = p.in[22];
  size_t total = (size_t)T_ * 512 / 4;
  for (size_t e = (size_t)bidx() * 512 + tidx(); e < total; e += (size_t)gridDim.x * 512) {
    size_t idx = e * 4; int c = (int)(idx & 511);
    float4 zv = *(const float4*)(p.z + idx), y0 = *(const float4*)(p.yd + idx), y1 = *(const float4*)(p.yd + (size_t)T_ * 512 + idx);
    float4 dv = *(const float4*)(dsk + c);
    bf16x4 o;
    o[0] = (short)f2bf(geluf_(zv.x * dv.x + y0.x + y1.x)); o[1] = (short)f2bf(geluf_(zv.y * dv.y + y0.y + y1.y));
    o[2] = (short)f2bf(geluf_(zv.z * dv.z + y0.z + y1.z)); o[3] = (short)f2bf(geluf_(zv.w * dv.w + y0.w + y1.w));
    *(bf16x4*)(p.U + idx) = o;
  }
}

__device__ __forceinline__ void hg_scan_item(const Params& p, int item, int half, u16* smem) {
  constexpr int QLD = 136, TLD = 72;
  const int tid = tidx(), lane = tid & 63, wv = tid >> 6;
  const bool mma = wv < 4;
  const int l15 = lane & 15, lg = lane >> 4;
  u16* sQ = smem;
  u16* sK = sQ + 64 * QLD;
  u16* sKT = sK + 64 * QLD;
  u16* sVt = sKT + 128 * TLD;
  u16* sST = sVt + 32 * TLD;
  float* sEb = (float*)(sST + 32 * QLD);
  int vs = item & 3, d = (item >> 2) & 1, h = (item >> 3) & 7, bl = item >> 6;
  const size_t rbase = (size_t)bl * PB;
  const u16* lfp = p.hlf + (size_t)d * HR * 1024;
  u16* op = p.ho + (size_t)d * HR * 1024;
  f32x4 Sacc[2][2];
#pragma unroll
  for (int a = 0; a < 2; ++a)
#pragma unroll
    for (int c = 0; c < 2; ++c) Sacc[a][c] = (f32x4){0.f, 0.f, 0.f, 0.f};
  for (int e = tid; e < 32 * QLD; e += 512) sST[e] = 0;
  __syncthreads();
  float* sTot = sEb + 128;
  u16* sLF = sK;
  bf16x8 rq[2], rlf[2], rvv;
  auto prefetch = [&](int ch) {
#pragma unroll
    for (int i = 0; i < 2; ++i) {
      int id = tid + 512 * i; int s = id >> 4, c = id & 15;
      size_t row = rbase + pos_of(d, ch * 64 + s);
      rq[i] = *(const bf16x8*)(p.hq + row * 1024 + h * 128 + c * 8);
      rlf[i] = *(const bf16x8*)(lfp + row * 1024 + h * 128 + c * 8);
    }
    if (tid < 256) {
      int s = tid >> 2, c = tid & 3;
      size_t row = rbase + pos_of(d, ch * 64 + s);
      rvv = *(const bf16x8*)(p.hv + row * 1024 + h * 128 + vs * 32 + c * 8);
    }
  };
  prefetch(0);
  for (int ch = 0; ch < 68; ++ch) {
#pragma unroll
    for (int i = 0; i < 2; ++i) {
      int id = tid + 512 * i; int s = id >> 4, c = id & 15;
      *(bf16x8*)(sQ + s * QLD + c * 8) = rq[i];
      *(bf16x8*)(sLF + s * QLD + c * 8) = rlf[i];
    }
    if (tid < 256) {
      int s = tid >> 2, c = tid & 3;
#pragma unroll
      for (int e = 0; e < 8; ++e) sVt[(c * 8 + e) * TLD + s] = (u16)rvv[e];
    }
    __syncthreads();
    if (ch + 1 < 68) prefetch(ch + 1);
    {
      const int j = tid & 127, sg = tid >> 7;
      float fv[16], pr[16];
      float run = 1.f;
#pragma unroll
      for (int e = 0; e < 16; ++e) {
        float lf = __half2float(__ushort_as_half(sLF[(16 * sg + e) * QLD + j]));
        fv[e] = __expf(lf);
        run *= fv[e];
        pr[e] = run;
      }
      sTot[sg * 128 + j] = run;
      __syncthreads();
      float p0 = sTot[j], p1 = sTot[128 + j], p2 = sTot[256 + j], p3 = sTot[384 + j];
      float scale = (sg == 0) ? 1.f : (sg == 1) ? p0 : (sg == 2) ? p0 * p1 : p0 * p1 * p2;
      if (sg == 0) sEb[j] = p0 * p1 * p2 * p3;
#pragma unroll
      for (int e8 = 0; e8 < 16; e8 += 8) {
        bf16x8 kt8;
#pragma unroll
        for (int e = 0; e < 8; ++e) {
          int s = 16 * sg + e8 + e;
          float eb = pr[e8 + e] * scale;
          float kin = (1.f - fv[e8 + e]) * __builtin_amdgcn_rcpf(eb);
          float qv = bf2f(sQ[s * QLD + j]);
          sQ[s * QLD + j] = f2bf(qv * eb);
          u16 kb = f2bf(kin);
          sK[s * QLD + j] = kb;
          kt8[e] = (short)kb;
        }
        *(bf16x8*)(sKT + j * TLD + 16 * sg + e8) = kt8;
      }
    }
    __syncthreads();
    if (mma) {
    bf16x8 qfr[4], kfr[2][4], vop[2][2], stf[2][4], ktf[2][2], vbf[2][2];
    f32x4 att[4];
#pragma unroll
    for (int ks = 0; ks < 4; ++ks) qfr[ks] = *(const bf16x8*)(sQ + (16 * wv + l15) * QLD + ks * 32 + lg * 8);
#pragma unroll
    for (int ms = 0; ms < 2; ++ms)
#pragma unroll
      for (int ks = 0; ks < 4; ++ks) kfr[ms][ks] = *(const bf16x8*)(sK + (16 * ms + l15) * QLD + ks * 32 + lg * 8);
#pragma unroll
    for (int md = 0; md < 2; ++md)
#pragma unroll
      for (int kb = 0; kb < 2; ++kb) ktf[md][kb] = *(const bf16x8*)(sKT + (32 * wv + 16 * md + l15) * TLD + kb * 32 + lg * 8);
#pragma unroll
    for (int nv = 0; nv < 2; ++nv)
#pragma unroll
      for (int kb = 0; kb < 2; ++kb) vbf[nv][kb] = *(const bf16x8*)(sVt + (16 * nv + l15) * TLD + kb * 32 + lg * 8);
    __builtin_amdgcn_sched_barrier(0);
#pragma unroll
    for (int ms = 0; ms < 2; ++ms) {
      att[ms] = (f32x4){0.f, 0.f, 0.f, 0.f};
#pragma unroll
      for (int ks = 0; ks < 4; ++ks) att[ms] = __builtin_amdgcn_mfma_f32_16x16x32_bf16(kfr[ms][ks], qfr[ks], att[ms], 0, 0, 0);
    }
#pragma unroll
    for (int md = 0; md < 2; ++md)
#pragma unroll
      for (int kb = 0; kb < 2; ++kb)
#pragma unroll
        for (int nv = 0; nv < 2; ++nv)
          Sacc[md][nv] = __builtin_amdgcn_mfma_f32_16x16x32_bf16(ktf[md][kb], vbf[nv][kb], Sacc[md][nv], 0, 0, 0);
    __builtin_amdgcn_sched_barrier(0);
#pragma unroll
    for (int ms = 0; ms < 2; ++ms)
#pragma unroll
      for (int ks = 0; ks < 4; ++ks) kfr[ms][ks] = *(const bf16x8*)(sK + (16 * (2 + ms) + l15) * QLD + ks * 32 + lg * 8);
#pragma unroll
    for (int nv = 0; nv < 2; ++nv) {
#pragma unroll
      for (int kb = 0; kb < 2; ++kb) {
        const u16* vp = sVt + (16 * nv + l15) * TLD + 32 * kb + 4 * lg;
        bf16x4 a0 = *(const bf16x4*)vp, a1 = *(const bf16x4*)(vp + 16);
        bf16x8 a;
        a[0] = a0[0]; a[1] = a0[1]; a[2] = a0[2]; a[3] = a0[3]; a[4] = a1[0]; a[5] = a1[1]; a[6] = a1[2]; a[7] = a1[3];
        vop[nv][kb] = a;
      }
#pragma unroll
      for (int ks = 0; ks < 4; ++ks) stf[nv][ks] = *(const bf16x8*)(sST + (16 * nv + l15) * QLD + ks * 32 + lg * 8);
    }
    __builtin_amdgcn_sched_barrier(0);
#pragma unroll
    for (int ms = 0; ms < 2; ++ms) {
      att[2 + ms] = (f32x4){0.f, 0.f, 0.f, 0.f};
#pragma unroll
      for (int ks = 0; ks < 4; ++ks) att[2 + ms] = __builtin_amdgcn_mfma_f32_16x16x32_bf16(kfr[ms][ks], qfr[ks], att[2 + ms], 0, 0, 0);
    }
    f32x4 oacc[2];
#pragma unroll
    for (int nv = 0; nv < 2; ++nv) {
      oacc[nv] = (f32x4){0.f, 0.f, 0.f, 0.f};
#pragma unroll
      for (int ks = 0; ks < 4; ++ks) oacc[nv] = __builtin_amdgcn_mfma_f32_16x16x32_bf16(stf[nv][ks], qfr[ks], oacc[nv], 0, 0, 0);
    }
    bf16x8 pfr[2];
    {
      int t = 16 * wv + l15;
#pragma unroll
      for (int ms = 0; ms < 4; ++ms)
#pragma unroll
        for (int rr = 0; rr < 4; ++rr) {
          int s = 16 * ms + 4 * lg + rr;
          float v = (s <= t) ? att[ms][rr] : 0.f;
          pfr[ms >> 1][(ms & 1) * 4 + rr] = (short)f2bf(v);
        }
    }
#pragma unroll
    for (int nv = 0; nv < 2; ++nv)
#pragma unroll
      for (int kb = 0; kb < 2; ++kb) oacc[nv] = __builtin_amdgcn_mfma_f32_16x16x32_bf16(vop[nv][kb], pfr[kb], oacc[nv], 0, 0, 0);
    {
      int t = 16 * wv + l15;
      size_t row = rbase + pos_of(d, ch * 64 + t);
#pragma unroll
      for (int nv = 0; nv < 2; ++nv) {
        bf16x4 o;
#pragma unroll
        for (int e = 0; e < 4; ++e) o[e] = (short)f2bf(oacc[nv][e]);
        *(bf16x4*)(op + row * 1024 + h * 128 + vs * 32 + 16 * nv + 4 * lg) = o;
      }
    }
    }
    __syncthreads();
    if (mma) {
#pragma unroll
    for (int md = 0; md < 2; ++md) {
      int d0 = 32 * wv + 16 * md + 4 * lg;
      float4 eb = *(const float4*)(sEb + d0);
#pragma unroll
      for (int nv = 0; nv < 2; ++nv) {
        Sacc[md][nv][0] *= eb.x; Sacc[md][nv][1] *= eb.y; Sacc[md][nv][2] *= eb.z; Sacc[md][nv][3] *= eb.w;
        bf16x4 o;
#pragma unroll
        for (int e = 0; e < 4; ++e) o[e] = (short)f2bf(Sacc[md][nv][e]);
        *(bf16x4*)(sST + (16 * nv + l15) * QLD + d0) = o;
      }
    }
    }
    __syncthreads();
  }
}

__device__ __forceinline__ void hg_readout_phase(const Params& p, int half) {
  int lane = tidx() & 63, wv = tidx() >> 6;
  const float* ng = p.in[26];
  for (int rl = bidx() * 8 + wv; rl < HR; rl += gridDim.x * 8) {
    size_t o = (size_t)rl * 1024 + lane * 16;
    bf16x8 a0 = *(const bf16x8*)(p.ho + o), a1 = *(const bf16x8*)(p.ho + o + 8);
    bf16x8 b0 = *(const bf16x8*)(p.ho + (size_t)HR * 1024 + o), b1 = *(const bf16x8*)(p.ho + (size_t)HR * 1024 + o + 8);
    bf16x8 g0 = *(const bf16x8*)(p.hsg + o), g1 = *(const bf16x8*)(p.hsg + o + 8);
    float v[16]; float ss = 0.f;
#pragma unroll
    for (int e = 0; e < 8; ++e) {
      v[e] = bf2f((u16)a0[e]) + bf2f((u16)b0[e]);
      v[8 + e] = bf2f((u16)a1[e]) + bf2f((u16)b1[e]);
    }
#pragma unroll
    for (int e = 0; e < 16; ++e) ss += v[e] * v[e];
    ss += __shfl_xor(ss, 1); ss += __shfl_xor(ss, 2); ss += __shfl_xor(ss, 4);
    float rstd = rsqrtf(ss * (1.f / 128.f) + EPS);
    bf16x8 o0, o1;
#pragma unroll
    for (int e = 0; e < 8; ++e) {
      o0[e] = (short)f2bf(v[e] * rstd * ng[lane * 16 + e] * bf2f((u16)g0[e]));
      o1[e] = (short)f2bf(v[8 + e] * rstd * ng[lane * 16 + 8 + e] * bf2f((u16)g1[e]));
    }
    size_t uo = ((size_t)half * HR + rl) * 1024 + lane * 16;
    *(bf16x8*)(p.U + uo) = o0; *(bf16x8*)(p.U + uo + 8) = o1;
  }
}

__device__ __forceinline__ void convgate_phase(const Params& p, int layer) {
  const float* cw = p.in[32] + (size_t)layer * 3 * F2;
  const float* cb = p.in[33] + (size_t)layer * F2;
  const size_t total = (size_t)HR * (F_ / 8);
  for (size_t e = (size_t)bidx() * 512 + tidx(); e < total; e += (size_t)gridDim.x * 512) {
    int rl = (int)(e / (F_ / 8)); int f = (int)(e % (F_ / 8)) * 8;
    int pp = rl % PB;
    bool hasp = (pp != 0) && (pp != CTX);
    bool hasn = (pp != CTX - 1) && (pp != PB - 1);
    const u16* hrow = p.H + (size_t)rl * F2;
    float a[8], gq[8];
#pragma unroll
    for (int part = 0; part < 2; ++part) {
      int fo = f + part * F_;
      bf16x8 c1 = *(const bf16x8*)(hrow + fo);
      bf16x8 c0 = c1, c2 = c1;
      if (hasp) c0 = *(const bf16x8*)(hrow - F2 + fo);
      if (hasn) c2 = *(const bf16x8*)(hrow + F2 + fo);
      float* dst = part == 0 ? a : gq;
#pragma unroll
      for (int k = 0; k < 8; ++k) {
        float v = bf2f((u16)c1[k]) * cw[F2 + fo + k] + cb[fo + k];
        if (hasp) v += bf2f((u16)c0[k]) * cw[fo + k];
        if (hasn) v += bf2f((u16)c2[k]) * cw[2 * F2 + fo + k];
        dst[k] = v;
      }
    }
    bf16x8 o;
#pragma unroll
    for (int k = 0; k < 8; ++k) o[k] = (short)f2bf(a[k] * siluf_(gq[k]));
    *(bf16x8*)(p.act + (size_t)rl * F_ + f) = o;
  }
}

constexpr int SMEM_BYTES = 74240;
enum { T_PREP = 0, T_NORM, T_GEMM, T_LATNORM, T_ATTN_MLA, T_S5A, T_S5B, T_S5C, T_S5GELU, T_HGSCAN, T_HGRO, T_ATTN_NA, T_CONVGATE, T_FINAL, T_NONE };
struct PD { int type, layer, set, half; GA g, g2; };

__device__ __forceinline__ void get_phase(const Params& p, int target, PD& pd) {
  int ph = 0;
  pd.type = T_NONE; pd.layer = 0; pd.set = 0; pd.half = 0;
  pd.g = GA{}; pd.g2 = GA{};
#define AT(code) { if (ph == target) { code } ++ph; }
  AT(pd.type = T_PREP;)
  for (int layer = 0; layer < 4; ++layer) {
    AT(pd.type = T_NORM; pd.layer = layer; pd.set = 0;)
    if (layer == 0) {
      AT(pd.type = T_GEMM; GA& g = pd.g; g.A = p.U; g.lda = 1024; g.Bt = p.w_mla_in; g.K = 1024; g.mt = T_ / 256; g.nt = 3; g.mode = E_LAT; g.o0 = p.lat;)
      AT(pd.type = T_LATNORM;)
      AT(pd.type = T_GEMM; GA& g = pd.g; g.A = p.qn; g.lda = 384; g.Bt = p.w_mla_q; g.K = 384; g.mt = T_ / 256; g.nt = 6; g.mode = E_BF16; g.o0 = p.Qm; g.ldo = 1536;
         GA& g2 = pd.g2; g2.A = p.kvn; g2.lda = 256; g2.Bt = p.w_mla_kv; g2.K = 256; g2.mt = T_ / 256; g2.nt = 8; g2.mode = E_KV; g2.o0 = p.Kn; g2.o1 = p.Vm;)
      AT(pd.type = T_ATTN_MLA;)
      AT(pd.type = T_GEMM; GA& g = pd.g; g.A = p.U; g.lda = 1024; g.Bt = p.w_mla_out; g.K = 1024; g.mt = T_ / 256; g.nt = 4; g.mode = E_RES; g.layer = 0; g.set = 0;)
    } else if (layer == 1) {
      AT(pd.type = T_GEMM; GA& g = pd.g; g.A = p.U; g.lda = 1024; g.Bt = p.w_s5_in; g.K = 1024; g.mt = T_ / 256; g.nt = 2; g.mode = E_F32; g.o0 = p.z; g.ldo = 512;)
      AT(pd.type = T_S5A;)
      AT(pd.type = T_S5B;)
      AT(pd.type = T_S5C;)
      AT(pd.type = T_S5GELU;)
      AT(pd.type = T_GEMM; GA& g = pd.g; g.A = p.U; g.lda = 512; g.Bt = p.w_s5_glu; g.K = 512; g.mt = T_ / 256; g.nt = 8; g.mode = E_GLU; g.layer = 1; g.set = 0;)
    } else if (layer == 2) {
      for (int half = 0; half < 2; ++half) {
        AT(pd.type = T_GEMM; GA& g = pd.g; g.A = p.U; g.lda = 1024; g.Bt = p.w_hg_in; g.K = 1024; g.row0 = half * HR; g.mt = HR / 256; g.nt = 20; g.mode = E_HG; g.orb = half * HR;)
        AT(pd.type = T_HGSCAN; pd.half = half;)
        AT(pd.type = T_HGRO; pd.half = half;)
      }
      AT(pd.type = T_GEMM; GA& g = pd.g; g.A = p.U; g.lda = 1024; g.Bt = p.w_hg_out; g.K = 1024; g.mt = T_ / 256; g.nt = 4; g.mode = E_RES; g.layer = 2; g.set = 0;)
    } else {
      AT(pd.type = T_GEMM; GA& g = pd.g; g.A = p.U; g.lda = 1024; g.Bt = p.w_na_qkv; g.K = 1024; g.mt = T_ / 256; g.nt = 12; g.mode = E_BF16; g.o0 = p.QKV; g.ldo = 3072;)
      AT(pd.type = T_ATTN_NA;)
      AT(pd.type = T_GEMM; GA& g = pd.g; g.A = p.U; g.lda = 1024; g.Bt = p.w_na_out; g.K = 1024; g.mt = T_ / 256; g.nt = 4; g.mode = E_RES; g.layer = 3; g.set = 0;)
    }
    AT(pd.type = T_NORM; pd.layer = layer; pd.set = 1;)
    AT(pd.type = T_GEMM; GA& g = pd.g; g.A = p.U; g.lda = 1024; g.Bt = p.w_up[layer]; g.K = 1024; g.mt = 138; g.nt = 22; g.mode = E_FFNUP; g.layer = layer;)
    AT(pd.type = T_GEMM; GA& g = pd.g; g.A = p.act; g.lda = F_; g.Bt = p.w_down[layer]; g.K = F_; g.mt = T_ / 256; g.nt = 4; g.mode = E_RES; g.layer = layer; g.set = 1;)
  }
  AT(pd.type = T_FINAL;)
#undef AT
}


#define XB_TMO      128
#define XB_XCNT(j)  (256  + 64 * (j))
#define XB_XSUB(j)  (1280 + 64 * (j))
#define XB_XGEN(j)  (2304 + 64 * (j))
#define XB_TOP      3328
#define XB_TOPGEN   3392
#define XCD_BAR_WORDS 3456
#define XB_SPIN_CAP (1u << 23)
#define LAS __attribute__((address_space(3)))
__device__ __forceinline__ unsigned xb_ld(unsigned* p) { return __hip_atomic_load(p, __ATOMIC_RELAXED, __HIP_MEMORY_SCOPE_AGENT); }
__device__ __forceinline__ unsigned xb_add(unsigned* p, unsigned v) { return __hip_atomic_fetch_add(p, v, __ATOMIC_RELAXED, __HIP_MEMORY_SCOPE_AGENT); }
__device__ __forceinline__ unsigned xb_xcc_id() { return (unsigned)__builtin_amdgcn_s_getreg((3 << 11) | 20) & 0xFu; }
#define XB_SPIN(cond, bar) do { unsigned _sp = 0; while (cond) { __builtin_amdgcn_s_sleep(1); \
    if ((++_sp & 255u) == 0u) { if (xb_ld(&(bar)[XB_TMO])) break; if (_sp > XB_SPIN_CAP) { atomicAdd(&(bar)[XB_TMO], 1u); break; } } } } while (0)
struct XcdBarrier { unsigned* bar; unsigned x; volatile LAS unsigned* st; };
__device__ __forceinline__ XcdBarrier xcd_barrier_post(unsigned* bar, volatile LAS unsigned* st) {
  XcdBarrier b; b.bar = bar; b.x = xb_xcc_id(); b.st = st;
  if (threadIdx.x == 0) (void)xb_add(&bar[XB_XCNT(b.x)], 1u);
  return b;
}
__device__ __forceinline__ void xcd_barrier_complete(unsigned* bar, unsigned x, unsigned& nloc, unsigned& nx) {
  const unsigned G = gridDim.x * gridDim.y * gridDim.z;
  unsigned sum, cnt, mine, sp = 0u;
  for (;;) {
    sum = 0u; cnt = 0u; mine = 0u;
#pragma unroll
    for (unsigned j = 0; j < 16; ++j) { const unsigned c = xb_ld(&bar[XB_XCNT(j)]); sum += c; cnt += (c > 0u) ? 1u : 0u; mine = (j == x) ? c : mine; }
    if (sum == G) break;
    __builtin_amdgcn_s_sleep(1);
    if ((++sp & 255u) == 0u) { if (xb_ld(&bar[XB_TMO])) break; if (sp > XB_SPIN_CAP) { atomicAdd(&bar[XB_TMO], 1u); break; } }
  }
  nloc = mine > 0u ? mine : 1u; nx = cnt > 0u ? cnt : 1u;
}
__device__ __forceinline__ void xcd_barrier(const XcdBarrier& b) {
  asm volatile("s_waitcnt vmcnt(0)" ::: "memory");
  __syncthreads();
  if (threadIdx.x == 0) {
    unsigned* bar = b.bar;
    __builtin_amdgcn_s_waitcnt(0);
    unsigned nloc = b.st[0], nx = b.st[1];
    if (nloc == 0u) { xcd_barrier_complete(bar, b.x, nloc, nx); b.st[0] = nloc; b.st[1] = nx; }
    const unsigned old = xb_add(&bar[XB_XSUB(b.x)], 1u);
    const unsigned gen = old / nloc;
    if (old + 1u == (gen + 1u) * nloc) {
      __builtin_amdgcn_fence(__ATOMIC_RELEASE, "agent");
      asm volatile("s_waitcnt vmcnt(0)" ::: "memory");
      const unsigned og = xb_add(&bar[XB_TOP], 1u);
      const unsigned tg = og / nx;
      if (og + 1u == (tg + 1u) * nx) xb_add(&bar[XB_TOPGEN], 1u);
      else XB_SPIN(xb_ld(&bar[XB_TOPGEN]) == tg, bar);
      __builtin_amdgcn_fence(__ATOMIC_ACQUIRE, "agent");
      xb_add(&bar[XB_XGEN(b.x)], 1u);
      asm volatile("s_waitcnt vmcnt(0)" ::: "memory");
    } else {
      XB_SPIN(xb_ld(&bar[XB_XGEN(b.x)]) == gen, bar);
      __builtin_amdgcn_fence(__ATOMIC_ACQUIRE, "agent");
      asm volatile("s_waitcnt vmcnt(0)" ::: "memory");
    }
  }
  __syncthreads();
}

constexpr int SMEM_HALF = 74240;
#define VLOOP(n, call, ndry) \
  for (int k_ = 0; k_ * VG < (n); ++k_) { int it = vbid + k_ * VG; \
    if (it < (n)) { call; } else { for (int q_ = 0; q_ < (ndry); ++q_) __syncthreads(); } }

__global__ void __launch_bounds__(512, 2) mega(Params p, int ph_lo, int ph_hi) {
  cg::grid_group grid = cg::this_grid();
  __shared__ __attribute__((aligned(16))) unsigned char smem_raw[2 * SMEM_HALF + 16];
  u16* smem = (u16*)smem_raw;
  const int G = gridDim.x, bid = bidx();
  volatile LAS unsigned* xst = (volatile LAS unsigned*)(smem_raw + 2 * SMEM_HALF);
  if (threadIdx.x == 0) { xst[0] = 0u; xst[1] = 0u; }
  __syncthreads();
  XcdBarrier xb = xcd_barrier_post(p.bar, xst);
  for (int ph = ph_lo; ph < ph_hi; ++ph) {
    if (ph > ph_lo) { if (ph == ph_lo + 1) grid.sync(); else xcd_barrier(xb); }
    PD pd;
    get_phase(p, ph, pd);
    pd.g.scale = 1.f; pd.g2.scale = 1.f;
    const int vh = tidx() >> 8;
    const int vbid = bid * 2 + vh, VG = 2 * G;
    u16* smh = (u16*)(smem_raw + vh * SMEM_HALF);
    float* smfh = (float*)smh;
#ifdef PROBE_MASK
    const int reps = ((PROBE_MASK >> pd.type) & 1) ? 2 : 1;
    for (int rep = 0; rep < reps; ++rep) {
    if (rep > 0) { grid.sync(); pd.g.scale = 0.f; pd.g2.scale = 0.f; }
#endif
    switch (pd.type) {
      case T_PREP: {
        VLOOP(p.ntt, prep_transpose(p, it, smfh), 2)
        VLOOP(384, prep_mod(p, it, smfh), 3)
        VLOOP(17, prep_small(p, it), 0)
      } break;
      case T_NORM: modnorm_phase(p, pd.layer, pd.set, pd.set == 0 ? p.in[6] : p.in[7], (G == 256 && pd.set == 0 && pd.layer > 0) ? pd.layer - 1 : -1); break;
      case T_GEMM: {
        int t1 = pd.g.mt * pd.g.nt, t2 = pd.g2.mt * pd.g2.nt;
        int nall = t1 + t2;
        const bool splitk = (pd.g.mode == E_RES) && (pd.g.K == F_) && (t1 == 544) && (t2 == 0) && (G == 256);
        if (splitk) nall = 512;
        int chunk = (nall + 7) >> 3;
        int xcd = bid & 7, bl = bid >> 3, gl = G >> 3;
        int vend = min((xcd + 1) * chunk, nall);
        for (int v = xcd * chunk + bl; v < vend; v += gl) {
          bool first = v < t1;
          GA cur = first ? pd.g : pd.g2;
          int vv = first ? v : v - t1;
          int per = 8 * cur.nt;
          int sr = vv / per, rem = vv - sr * per;
          int full = cur.mt >> 3;
          int tn, tm;
          if (sr < full) { tn = rem >> 3; tm = sr * 8 + (rem & 7); }
          else { int rl = cur.mt & 7; tn = rem / rl; tm = full * 8 + (rem - tn * rl); }
          gemm_tile(p, cur, tm, tn, smem);
        }
        if (splitk) {
          GA cur = pd.g;
          int tile = bid >> 3, c = bid & 7;
          int tn = tile >> 3, tm = 128 + (tile & 7);
          int nks = cur.K >> 6;
          cur.kb = (c * nks) >> 3; cur.ke = ((c + 1) * nks) >> 3;
          cur.mode = E_PART; cur.o0 = (cur.layer == 3 ? p.part3 : p.part0) + (size_t)c * 2048 * 1024; cur.orb = 32768;
          gemm_tile(p, cur, tm, tn, smem);
        }
      } break;
      case T_LATNORM: latnorm_phase(p); break;
      case T_ATTN_MLA: {
        if (G == 256) {
          const int x = bid & 7, bl = bid >> 3;
          for (int k = 0; k < 8; ++k) attn_item<96, 2, 0, 8, 2>(p, (k * 16 + x * 2 + (bl >> 4)) * 16 + (bl & 15), smem);
        } else {
          for (int it = bid; it < 2048; it += G) attn_item<96, 2, 0, 8, 2>(p, it, smem);
        }
        for (int it = bid; it < 128; it += G) attn_item<96, 2, 1, 8, 2>(p, it, smem);
      } break;
      case T_S5A: { VLOOP(8704, s5_scan_item<false>(p, it, smfh), 8) } break;
      case T_S5B: for (int it = bid; it < 64; it += G) s5_combine_item(p, it); break;
      case T_S5C: { VLOOP(8704, s5_scan_item<true>(p, it, smfh), 12) } break;
      case T_S5GELU: s5_gelu_phase(p); break;
      case T_HGSCAN: {
        for (int it = bid; it < 256; it += G) {
          const int itx = (G == 256) ? ((((it & 7) * 8 + (it >> 5)) << 2) | ((it >> 3) & 3)) : it;
          hg_scan_item(p, itx, pd.half, smem);
        }
      } break;
      case T_HGRO: hg_readout_phase(p, pd.half); break;
      case T_ATTN_NA: {
        if (G == 256) {
          const int x = bid & 7, vb = (bid >> 3) * 2 + vh;
          for (int k = 0; k < 8; ++k) attn_item<64, 2, 2, 4, 1>(p, (k * 16 + x * 2 + (vb >> 5)) * 32 + (vb & 31), smh);
        } else { VLOOP(4096, (attn_item<64, 2, 2, 4, 1>(p, it, smh)), 14) }
      } break;
      case T_FINAL: final_norm_phase(p, G == 256); break;
      default: break;
    }
#ifdef PROBE_MASK
    }
#endif
  }
}

constexpr int N_PHASES = 39;

extern "C" void kernel_launch(void* const* d_in, const int* in_sizes, int n_in, void* d_out, int out_size,
                              void* d_ws, size_t ws_size, hipStream_t stream) {
  Params p;
  memset(&p, 0, sizeof(p));
  for (int i = 0; i < 36; ++i) p.in[i] = (const float*)d_in[i];
  p.out = (float*)d_out;
  char* ws = (char*)d_ws;
  size_t off = 0;
  auto take = [&](size_t bytes) { char* r = ws + off; off += (bytes + 255) & ~(size_t)255; return r; };
  p.bar = (unsigned*)take(XCD_BAR_WORDS * 4);
  p.X = (float*)take((size_t)T_ * D_ * 4);
  p.U = (u16*)take((size_t)T_ * D_ * 2);
  p.mod = (float*)take((size_t)4 * 9 * 6144 * 4);
  p.cs = (float*)take(4096);
  p.lb2 = (float*)take(4096);
  p.lamb = (float*)take(2 * 32 * 64 * 2 * 4);
  p.bbar = (float*)take(2 * 32 * 64 * 16 * 2 * 4);
  int ntd = 0, ntt = 0;
  auto addw = [&](const float* src, int K, int N, int Npad, int mode) -> u16* {
    u16* dst = (u16*)take((size_t)Npad * K * 2);
    p.td[ntd].src = src; p.td[ntd].dst = dst; p.td[ntd].K = K; p.td[ntd].N = N; p.td[ntd].Npad = Npad; p.td[ntd].mode = mode;
    ntt += (K / 64) * (Npad / 64); ++ntd;
    return dst;
  };
  p.w_mla_in = addw(p.in[8], 1024, 672, 768, 0);
  p.w_mla_q = addw(p.in[10], 384, 1536, 1536, 0);
  p.w_mla_kv = addw(p.in[12], 256, 2048, 2048, 0);
  p.w_mla_out = addw(p.in[13], 1024, 1024, 1024, 0);
  p.w_s5_in = addw(p.in[14], 1024, 512, 512, 0);
  p.w_s5_glu = addw(p.in[23], 512, 2048, 2048, 1);
  p.w_hg_in = addw(p.in[24], 1024, 5120, 5120, 0);
  p.w_hg_out = addw(p.in[27], 1024, 1024, 1024, 0);
  p.w_na_qkv = addw(p.in[28], 1024, 3072, 3072, 0);
  p.w_na_out = addw(p.in[30], 1024, 1024, 1024, 0);
  for (int i = 0; i < 4; ++i) {
    p.w_up[i] = addw(p.in[31] + (size_t)i * 1024 * F2, 1024, F2, F2, 2);
    p.w_down[i] = addw(p.in[34] + (size_t)i * F_ * 1024, F_, 1024, 1024, 0);
  }
  p.ntd = ntd; p.ntt = ntt;
  char* S = ws + off;
  char* O2 = (char*)d_out;
  p.lat = (float*)S; p.Qm = (u16*)S; p.Kn = (u16*)(S + (size_t)T_ * 1536 * 2);
  p.Vm = (u16*)O2; p.qn = (u16*)(O2 + (size_t)T_ * 1024 * 2); p.kvn = p.qn + (size_t)T_ * 384; p.kr = p.kvn + (size_t)T_ * 256;
  p.z = (float*)S; p.yd = (float*)(S + (size_t)T_ * 512 * 4); p.chst = (float*)O2; p.part0 = (float*)O2; p.part3 = (float*)p.U;
  p.hq = (u16*)S; p.hlf = p.hq + (size_t)HR * 1024; p.hv = p.hlf + (size_t)2 * HR * 1024; p.hsg = p.hv + (size_t)HR * 1024; p.ho = (u16*)O2;
  p.QKV = (u16*)S;
  p.H = (u16*)S; p.act = (u16*)S;

  static int grid_blocks = 0;
  if (!grid_blocks) {
    int dev = 0, cus = 0, per_cu = 0;
    (void)hipGetDevice(&dev);
    (void)hipDeviceGetAttribute(&cus, hipDeviceAttributeMultiprocessorCount, dev);
    (void)hipOccupancyMaxActiveBlocksPerMultiprocessor(&per_cu, mega, 512, 0);
    if (per_cu < 1) per_cu = 1;
    if (per_cu > 1) per_cu = 1;
    grid_blocks = cus * per_cu;
  }
  (void)hipMemsetAsync(p.bar, 0, XCD_BAR_WORDS * 4, stream);
#if ONE_LAUNCH
  int lo = 0, hi = N_PHASES;
  void* args[] = {&p, &lo, &hi};
  hipError_t e = hipLaunchCooperativeKernel((void*)mega, dim3(grid_blocks), dim3(512), args, 0, stream);
  if (e != hipSuccess) fprintf(stderr, "cooperative launch failed: %s (grid %d)\n", hipGetErrorString(e), grid_blocks);
#else
  for (int ph = 0; ph < N_PHASES; ++ph) {
    hipLaunchKernelGGL(mega, dim3(grid_blocks), dim3(512), 0, stream, p, ph, ph + 1);
  }
#endif
}
```

```cpp
#include <hip/hip_runtime.h>
#include <hip/hip_bf16.h>
#include <hip/hip_fp16.h>
#include <hip/hip_cooperative_groups.h>
#include <cstdio>
#include <cstring>
namespace cg = cooperative_groups;

#ifndef ONE_LAUNCH
#define ONE_LAUNCH 1
#endif

typedef __attribute__((ext_vector_type(8))) short bf16x8;
typedef __attribute__((ext_vector_type(4))) short bf16x4;
typedef __attribute__((ext_vector_type(4))) float f32x4;
typedef unsigned short u16;

constexpr int NB = 8, SEQ = 4096, CTX = 256, PB = 4352, T_ = 34816, D_ = 1024;
constexpr int F_ = 2816, F2 = 5632;
constexpr int HR = 17408;
constexpr float EPS = 1e-6f;
constexpr float LOG2E = 1.4426950408889634f;

struct TDesc { const float* src; u16* dst; int K, N, Npad, mode; };

struct Params {
  const float* in[36];
  float* out;
  unsigned* bar; float* part0; float* part3;
  float* X; u16* U; float* mod; float* cs; float* lb2; float* lamb; float* bbar;
  u16* w_mla_in; u16* w_mla_q; u16* w_mla_kv; u16* w_mla_out;
  u16* w_s5_in; u16* w_s5_glu; u16* w_hg_in; u16* w_hg_out; u16* w_na_qkv; u16* w_na_out;
  u16* w_up[4]; u16* w_down[4];
  float* lat; u16* Qm; u16* Kn; u16* Vm; u16* qn; u16* kvn; u16* kr;
  float* z; float* yd; float* chst;
  u16* hq; u16* hlf; u16* hv; u16* hsg; u16* ho;
  u16* QKV;
  u16* H; u16* act;
  TDesc td[20];
  int ntd; int ntt;
};

__device__ __forceinline__ int tidx() { int t = threadIdx.x; asm volatile("" : "+v"(t)); return t; }
__device__ __forceinline__ int vtid() { return tidx() & 255; }
__device__ __forceinline__ int bidx() { int t = blockIdx.x; asm volatile("" : "+s"(t)); return t; }
__device__ __forceinline__ u16 f2bf(float f) {
  unsigned u = __float_as_uint(f);
  u += 0x7fffu + ((u >> 16) & 1u);
  return (u16)(u >> 16);
}
typedef __attribute__((ext_vector_type(4))) unsigned u32x4;
typedef __attribute__((ext_vector_type(2))) float f32x2_t;
typedef __attribute__((ext_vector_type(2))) __bf16 bf16x2_t;
__device__ __forceinline__ unsigned pack_bf16(float a, float b) {
  f32x2_t v = {a, b};
  bf16x2_t r = __builtin_convertvector(v, bf16x2_t);
  return __builtin_bit_cast(unsigned, r);
}
__device__ __forceinline__ float vmax(float a, float b) { return __builtin_fmaxf(a, b); }
__device__ __forceinline__ float vmax3(float a, float b, float c) { return __builtin_fmaxf(__builtin_fmaxf(a, b), c); }
__device__ __forceinline__ float bf2f(u16 h) { return __uint_as_float(((unsigned)h) << 16); }
__device__ __forceinline__ float sigmoidf_(float x) { return 1.f / (1.f + __expf(-x)); }
__device__ __forceinline__ float siluf_(float x) { return x / (1.f + __expf(-x)); }
__device__ __forceinline__ float geluf_(float x) {
  float u = 0.7978845608028654f * (x + 0.044715f * x * x * x);
  return 0.5f * x * (1.f + tanhf(u));
}
__device__ __forceinline__ float wave_sum(float v) {
#pragma unroll
  for (int o = 32; o > 0; o >>= 1) v += __shfl_xor(v, o);
  return v;
}
__device__ __forceinline__ int brow_of(int row) {
  int b = row / PB; int pp = row - b * PB;
  return pp < CTX ? 8 : b;
}
__device__ __forceinline__ int pos_of(int d, int s) {
  return d == 0 ? s : (s < CTX ? (CTX - 1 - s) : (PB + CTX - 1 - s));
}

__device__ __forceinline__ const float* in_row(const Params& p, int row) {
  int b = row / PB, pp = row - b * PB;
  return (pp < CTX) ? (p.in[2] + ((size_t)b * CTX + pp) * D_) : (p.in[0] + ((size_t)b * SEQ + (pp - CTX)) * D_);
}
__device__ __forceinline__ int glu_map(int np, int halfn) {
  int tile = np >> 8, c = np & 255;
  int wn = c >> 6, s = (c & 63) >> 4;
  int f = tile * 128 + 32 * wn + 16 * (s & 1) + (c & 15);
  return f + ((s >= 2) ? halfn : 0);
}

__device__ __forceinline__ void prep_transpose(const Params& p, int item, float* ts) {
  int di = 0, rem = item;
  for (; di < p.ntd; ++di) {
    int nt = (p.td[di].K >> 6) * (p.td[di].Npad >> 6);
    if (rem < nt) break;
    rem -= nt;
  }
  const TDesc& t = p.td[di];
  int ntn = t.Npad >> 6;
  int kk0 = (rem / ntn) * 64, n0 = (rem % ntn) * 64;
  int tid = vtid();
#pragma unroll
  for (int i = 0; i < 4; ++i) {
    int kl = (tid >> 4) + 16 * i;
    int nl = (tid & 15) * 4;
    int np = n0 + nl;
    int sc = (t.mode == 1) ? glu_map(np, 1024) : ((t.mode == 2) ? glu_map(np, F_) : np);
    float4 v = make_float4(0.f, 0.f, 0.f, 0.f);
    if (np < t.N) { f32x4 t4 = __builtin_nontemporal_load((const f32x4*)(t.src + (size_t)(kk0 + kl) * t.N + sc)); v = make_float4(t4[0], t4[1], t4[2], t4[3]); }
    ts[(nl + 0) * 65 + kl] = v.x; ts[(nl + 1) * 65 + kl] = v.y;
    ts[(nl + 2) * 65 + kl] = v.z; ts[(nl + 3) * 65 + kl] = v.w;
  }
  __syncthreads();
  {
    int nl = tid >> 2, kq = (tid & 3) * 16;
    bf16x8 o0, o1;
#pragma unroll
    for (int e = 0; e < 8; ++e) { o0[e] = (short)f2bf(ts[nl * 65 + kq + e]); o1[e] = (short)f2bf(ts[nl * 65 + kq + 8 + e]); }
    u16* d = t.dst + (size_t)(n0 + nl) * t.K + kk0 + kq;
    *(bf16x8*)d = o0; *(bf16x8*)(d + 8) = o1;
  }
  __syncthreads();
}

__device__ __forceinline__ void prep_mod(const Params& p, int item, float* sm) {
  int i = item / 96, cc = item % 96;
  float* sc = sm;
  float* red = sm + 9 * 1024;
  int tid = vtid();
  for (int e = tid; e < 9 * 1024; e += 256) {
    int r = e >> 10, k = e & 1023;
    float v = (r < 8) ? p.in[1][r * 1024 + k] : p.in[3][k];
    sc[e] = siluf_(v);
  }
  __syncthreads();
  int kq = tid >> 6, col = tid & 63;
  int n = cc * 64 + col;
  float acc[9];
#pragma unroll
  for (int r = 0; r < 9; ++r) acc[r] = 0.f;
  const float* w = p.in[4] + (size_t)i * 1024 * 6144 + n;
  for (int k = kq * 256; k < kq * 256 + 256; ++k) {
    float wv = __builtin_nontemporal_load(w + (size_t)k * 6144);
#pragma unroll
    for (int r = 0; r < 9; ++r) acc[r] += sc[r * 1024 + k] * wv;
  }
#pragma unroll
  for (int r = 0; r < 9; ++r) red[(kq * 9 + r) * 64 + col] = acc[r];
  __syncthreads();
  for (int e = tid; e < 9 * 64; e += 256) {
    int r = e >> 6, c = e & 63;
    float s = red[(0 * 9 + r) * 64 + c] + red[(1 * 9 + r) * 64 + c] + red[(2 * 9 + r) * 64 + c] + red[(3 * 9 + r) * 64 + c];
    int nn = cc * 64 + c;
    p.mod[(size_t)(i * 9 + r) * 6144 + nn] = s + p.in[5][i * 6144 + nn];
  }
  __syncthreads();
}

__device__ __forceinline__ void prep_copy(const Params& p, int item) {
  int tid = vtid();
#pragma unroll 4
  for (int i = 0; i < 16; ++i) {
    int row = item * 16 + i;
    int b = row / PB, pp = row - b * PB;
    const float* src = (pp < CTX) ? (p.in[2] + ((size_t)b * CTX + pp) * D_) : (p.in[0] + ((size_t)b * SEQ + (pp - CTX)) * D_);
    float4 v = *(const float4*)(src + tid * 4);
    *(float4*)(p.X + (size_t)row * D_ + tid * 4) = v;
  }
}

__device__ __forceinline__ void prep_small(const Params& p, int item) {
  int tid = vtid();
  if (item == 0) {
    for (int e = tid; e < 512; e += 256) {
      int pos = e >> 3, j = e & 7;
      float inv = powf(10000.f, -(float)j / 8.f);
      float ang = (float)pos * inv;
      p.cs[e * 2] = cosf(ang); p.cs[e * 2 + 1] = sinf(ang);
    }
    for (int c = tid; c < 1024; c += 256) {
      float x0 = p.in[25][c], x1 = p.in[25][1024 + c], x2 = p.in[25][2048 + c], x3 = p.in[25][3072 + c];
      float m = fmaxf(fmaxf(x0, x1), fmaxf(x2, x3));
      float e0 = expf(x0 - m), e1 = expf(x1 - m), e2 = expf(x2 - m), e3 = expf(x3 - m);
      p.lb2[c] = (e1 + e2) / (e0 + e1 + e2 + e3);
    }
  } else {
    int idx = (item - 1) * 256 + tid;
    int dg = idx >> 6;
    float lre = p.in[15][idx], lim = p.in[16][idx];
    float dt = expf(p.in[17][dg]);
    float ar = lre * dt, ai = lim * dt;
    float er = expf(ar);
    float lbr = er * cosf(ai), lbi = er * sinf(ai);
    p.lamb[idx * 2] = lbr; p.lamb[idx * 2 + 1] = lbi;
    float nr = lbr - 1.f, ni = lbi;
    float den = lre * lre + lim * lim;
    float qr = (nr * lre + ni * lim) / den, qi = (ni * lre - nr * lim) / den;
    for (int c = 0; c < 16; ++c) {
      float br = p.in[18][idx * 16 + c], bi = p.in[19][idx * 16 + c];
      p.bbar[(idx * 16 + c) * 2] = qr * br - qi * bi;
      p.bbar[(idx * 16 + c) * 2 + 1] = qr * bi + qi * br;
    }
  }
}

__device__ __forceinline__ void modnorm_phase(const Params& p, int layer, int set, const float* gsrc, int fixl) {
  int lane = tidx() & 63, wv = tidx() >> 6;
  const float* g = gsrc + layer * 1024;
  for (int row0 = (bidx() * 8 + wv) * 4; row0 < T_; row0 += gridDim.x * 32) {
    float4 v[4][4]; float ss[4];
#pragma unroll
    for (int rr = 0; rr < 4; ++rr) {
      const float* x = (layer == 0 && set == 0) ? in_row(p, row0 + rr) : (p.X + (size_t)(row0 + rr) * D_);
#pragma unroll
      for (int i = 0; i < 4; ++i) v[rr][i] = *(const float4*)(x + i * 256 + lane * 4);
    }
    if (fixl >= 0 && row0 >= 32768) {
      const float* gate = p.mod + (size_t)(fixl * 9 + brow_of(row0)) * 6144 + 5 * 1024;
#pragma unroll
      for (int i = 0; i < 4; ++i) {
        int c = i * 256 + lane * 4;
        float4 gt = *(const float4*)(gate + c);
#pragma unroll
        for (int rr = 0; rr < 4; ++rr) {
          float4 a = make_float4(0.f, 0.f, 0.f, 0.f);
#pragma unroll
          for (int q = 0; q < 8; ++q) {
            float4 t = *(const float4*)(p.part0 + ((size_t)q * 2048 + (row0 + rr - 32768)) * 1024 + c);
            a.x += t.x; a.y += t.y; a.z += t.z; a.w += t.w;
          }
          v[rr][i].x += gt.x * a.x; v[rr][i].y += gt.y * a.y; v[rr][i].z += gt.z * a.z; v[rr][i].w += gt.w * a.w;
          *(float4*)(p.X + (size_t)(row0 + rr) * D_ + c) = v[rr][i];
        }
      }
    }
#pragma unroll
    for (int rr = 0; rr < 4; ++rr) {
      float s = 0.f;
#pragma unroll
      for (int i = 0; i < 4; ++i) s += v[rr][i].x * v[rr][i].x + v[rr][i].y * v[rr][i].y + v[rr][i].z * v[rr][i].z + v[rr][i].w * v[rr][i].w;
      ss[rr] = rsqrtf(wave_sum(s) * (1.f / 1024.f) + EPS);
    }
    const float* md = p.mod + (size_t)(layer * 9 + brow_of(row0)) * 6144;
    const float* sh = md + (3 * set) * 1024; const float* sc = md + (3 * set + 1) * 1024;
#pragma unroll
    for (int i = 0; i < 4; ++i) {
      int c = i * 256 + lane * 4;
      float4 gg = *(const float4*)(g + c), s1 = *(const float4*)(sc + c), s0 = *(const float4*)(sh + c);
      gg.x *= (1.f + s1.x); gg.y *= (1.f + s1.y); gg.z *= (1.f + s1.z); gg.w *= (1.f + s1.w);
#pragma unroll
      for (int rr = 0; rr < 4; ++rr) {
        float rstd = ss[rr];
        bf16x4 o;
        o[0] = (short)f2bf(v[rr][i].x * rstd * gg.x + s0.x);
        o[1] = (short)f2bf(v[rr][i].y * rstd * gg.y + s0.y);
        o[2] = (short)f2bf(v[rr][i].z * rstd * gg.z + s0.z);
        o[3] = (short)f2bf(v[rr][i].w * rstd * gg.w + s0.w);
        *(bf16x4*)(p.U + (size_t)(row0 + rr) * D_ + c) = o;
      }
    }
  }
}

__device__ __forceinline__ void final_norm_phase(const Params& p, bool fix) {
  int lane = tidx() & 63, wv = tidx() >> 6;
  const float* g = p.in[35];
  for (int r = bidx() * 8 + wv; r < NB * SEQ; r += gridDim.x * 8) {
    int b = r / SEQ, t = r - b * SEQ;
    const int grow = b * PB + CTX + t;
    const float* x = p.X + (size_t)grow * D_;
    float4 v[4]; float ss = 0.f;
#pragma unroll
    for (int i = 0; i < 4; ++i) v[i] = *(const float4*)(x + i * 256 + lane * 4);
    if (fix && grow >= 32768) {
      const float* gate = p.mod + (size_t)(3 * 9 + b) * 6144 + 5 * 1024;
#pragma unroll
      for (int i = 0; i < 4; ++i) {
        int c = i * 256 + lane * 4;
        float4 gt = *(const float4*)(gate + c);
        float4 a = make_float4(0.f, 0.f, 0.f, 0.f);
#pragma unroll
        for (int q = 0; q < 8; ++q) {
          float4 tq = *(const float4*)(p.part3 + ((size_t)q * 2048 + (grow - 32768)) * 1024 + c);
          a.x += tq.x; a.y += tq.y; a.z += tq.z; a.w += tq.w;
        }
        v[i].x += gt.x * a.x; v[i].y += gt.y * a.y; v[i].z += gt.z * a.z; v[i].w += gt.w * a.w;
      }
    }
#pragma unroll
    for (int i = 0; i < 4; ++i) ss += v[i].x * v[i].x + v[i].y * v[i].y + v[i].z * v[i].z + v[i].w * v[i].w;
    ss = wave_sum(ss);
    float rstd = rsqrtf(ss * (1.f / 1024.f) + EPS);
#pragma unroll
    for (int i = 0; i < 4; ++i) {
      int c = i * 256 + lane * 4;
      float4 gg = *(const float4*)(g + c);
      float4 o = make_float4(v[i].x * rstd * gg.x, v[i].y * rstd * gg.y, v[i].z * rstd * gg.z, v[i].w * rstd * gg.w);
      { f32x4 o4 = {o.x, o.y, o.z, o.w}; __builtin_nontemporal_store(o4, (f32x4*)(p.out + (size_t)r * D_ + c)); }
    }
  }
}

struct GA {
  const u16* A; const u16* Bt; int lda, K; int row0, arb, mt, nt; int mode; int layer, set;
  void* o0; void* o1; int ldo, orb; float scale;
  int kb, ke;
};
enum { E_LAT = 0, E_BF16 = 1, E_KV = 2, E_RES = 3, E_F32 = 4, E_GLU = 5, E_HG = 6, E_FFNUP = 7, E_PART = 8 };

constexpr int GLD = 72;

__device__ __forceinline__ void gemm_tile(const Params& p, const GA& g, int tm, int tn, u16* smem) {
  const int tid = tidx(), lane = tid & 63, wv = tid >> 6;
  const int wm = wv >> 2, wn = wv & 3;
  const int l15 = lane & 15, lg = lane >> 4;
  int m0 = g.row0 + tm * 256; const int n0 = tn * 256;
  int frow0 = 0;
  if (g.mode == E_FFNUP) { frow0 = 254 * tm - 1; m0 = 0; }
  unsigned char* sm8 = (unsigned char*)smem;
  const u16* Ag = g.A + (size_t)(m0 - g.arb) * g.lda;
  const u16* Bg = g.Bt + (size_t)n0 * g.K;
  f32x4 acc[8][4];
#pragma unroll
  for (int i = 0; i < 8; ++i)
#pragma unroll
    for (int j = 0; j < 4; ++j) acc[i][j] = (f32x4){0.f, 0.f, 0.f, 0.f};
  const int nk = g.K >> 6;
  auto glds_piece = [&](int kt, int buf, int i) {
    int q = wv * 4 + i;
    int r = 8 * q + (lane >> 3);
    int csrc = (lane & 7) ^ ((r >> 1) & 7);
    int ar = r;
    if (g.mode == E_FFNUP) ar = min(max(frow0 + r, 0), T_ - 1);
    const u16* ga = Ag + (size_t)ar * g.lda + kt * 64 + csrc * 8;
    const u16* gb = Bg + (size_t)r * g.K + kt * 64 + csrc * 8;
    unsigned char* la = sm8 + buf * 65536 + q * 1024 + lane * 16;
    __builtin_amdgcn_global_load_lds((const unsigned*)ga, (__attribute__((address_space(3))) unsigned*)la, 16, 0, 0);
    __builtin_amdgcn_global_load_lds((const unsigned*)gb, (__attribute__((address_space(3))) unsigned*)(la + 32768), 16, 0, 0);
  };
  const int kb = g.kb, ke = (g.ke > 0) ? g.ke : nk;
#pragma unroll
  for (int i = 0; i < 4; ++i) glds_piece(kb, 0, i);
  asm volatile("s_waitcnt vmcnt(0)" ::: "memory");
  __syncthreads();
  { const int k1 = (kb + 1 < ke) ? kb + 1 : kb; glds_piece(k1, 1, 0); glds_piece(k1, 1, 1); }
  const int sw = l15 >> 1;
  bf16x8 cb[4], ca[2];
  {
    const unsigned char* pa = sm8 + (wm * 128 + l15) * 128;
    const unsigned char* pb = sm8 + 32768 + (wn * 64 + l15) * 128;
    const int co = ((0 * 4 + lg) ^ sw) << 4;
#pragma unroll
    for (int j = 0; j < 4; ++j) cb[j] = *(const bf16x8*)(pb + j * 2048 + co);
    ca[0] = *(const bf16x8*)(pa + co); ca[1] = *(const bf16x8*)(pa + 2048 + co);
  }
  for (int kt = kb; kt < ke; ++kt) {
    const int buf = (kt - kb) & 1;
    const int ktn = (kt + 1 < ke) ? kt + 1 : kt;
    const unsigned char* pa = sm8 + buf * 65536 + (wm * 128 + l15) * 128;
    const unsigned char* pb = sm8 + buf * 65536 + 32768 + (wn * 64 + l15) * 128;
    const unsigned char* pan = sm8 + (buf ^ 1) * 65536 + (wm * 128 + l15) * 128;
    const unsigned char* pbn = sm8 + (buf ^ 1) * 65536 + 32768 + (wn * 64 + l15) * 128;
#pragma unroll
    for (int s = 0; s < 8; ++s) {
      const int ks = s >> 2, pp = s & 3;
      bf16x8 nb[4], na[2];
      if (s < 2) glds_piece(ktn, buf ^ 1, s + 2);
      if (s < 7) {
        const int ks2 = (s + 1) >> 2, p2 = (s + 1) & 3;
        const int co = ((ks2 * 4 + lg) ^ sw) << 4;
        if (p2 == 0) {
#pragma unroll
          for (int j = 0; j < 4; ++j) nb[j] = *(const bf16x8*)(pb + j * 2048 + co);
        }
        na[0] = *(const bf16x8*)(pa + (2 * p2) * 2048 + co);
        na[1] = *(const bf16x8*)(pa + (2 * p2 + 1) * 2048 + co);
      } else {
        asm volatile("s_waitcnt vmcnt(0)" ::: "memory");
        __syncthreads();
        { const int k2 = (kt + 2 < ke) ? kt + 2 : ke - 1; glds_piece(k2, buf, 0); glds_piece(k2, buf, 1); }
        const int co = ((0 * 4 + lg) ^ sw) << 4;
#pragma unroll
        for (int j = 0; j < 4; ++j) nb[j] = *(const bf16x8*)(pbn + j * 2048 + co);
        na[0] = *(const bf16x8*)(pan + co);
        na[1] = *(const bf16x8*)(pan + 2048 + co);
      }
#pragma unroll
      for (int ii = 0; ii < 2; ++ii)
#pragma unroll
        for (int j = 0; j < 4; ++j)
          acc[2 * pp + ii][j] = __builtin_amdgcn_mfma_f32_16x16x32_bf16(cb[j], ca[ii], acc[2 * pp + ii][j], 0, 0, 0);
      ca[0] = na[0]; ca[1] = na[1];
      if (s == 3 || s == 7) {
#pragma unroll
        for (int j = 0; j < 4; ++j) cb[j] = nb[j];
      }
      if (s & 1) __builtin_amdgcn_sched_barrier(0);
    }
  }
  asm volatile("s_waitcnt vmcnt(0)" ::: "memory");
  __syncthreads();
  if (g.mode == E_FFNUP) {
    u16* sT = smem;
#pragma unroll
    for (int i = 0; i < 8; ++i) {
      int lr = wm * 128 + 16 * i + l15;
#pragma unroll
      for (int j = 0; j < 4; ++j) {
        int cl = ((j >= 2) ? 128 : 0) + 32 * wn + 16 * (j & 1) + 4 * lg;
        f32x4 v = acc[i][j];
        bf16x4 o; o[0] = (short)f2bf(v[0]); o[1] = (short)f2bf(v[1]); o[2] = (short)f2bf(v[2]); o[3] = (short)f2bf(v[3]);
        *(bf16x4*)(sT + lr * 264 + cl) = o;
      }
    }
    __syncthreads();
    {
      const float* cw = p.in[32] + (size_t)g.layer * 3 * F2;
      const float* cb = p.in[33] + (size_t)g.layer * F2;
      const int f4 = (tid & 31) * 4;
      const int fg = tn * 128 + f4;
      float4 wa0 = *(const float4*)(cw + fg), wa1 = *(const float4*)(cw + F2 + fg), wa2 = *(const float4*)(cw + 2 * F2 + fg);
      float4 wg0 = *(const float4*)(cw + F_ + fg), wg1 = *(const float4*)(cw + F2 + F_ + fg), wg2 = *(const float4*)(cw + 2 * F2 + F_ + fg);
      float4 ba = *(const float4*)(cb + fg), bg = *(const float4*)(cb + F_ + fg);
#pragma unroll 4
      for (int it = 0; it < 16; ++it) {
        int lr = 1 + (tid >> 5) + 16 * it;
        int row = frow0 + lr;
        if (lr <= 254 && row < T_) {
          int pp = row % PB;
          bool hasp = (pp != 0) && (pp != CTX);
          bool hasn = (pp != CTX - 1) && (pp != PB - 1);
          float mp = hasp ? 1.f : 0.f, mn = hasn ? 1.f : 0.f;
          bf16x4 a0 = *(const bf16x4*)(sT + (lr - 1) * 264 + f4), a1 = *(const bf16x4*)(sT + lr * 264 + f4), a2 = *(const bf16x4*)(sT + (lr + 1) * 264 + f4);
          bf16x4 g0 = *(const bf16x4*)(sT + (lr - 1) * 264 + 128 + f4), g1 = *(const bf16x4*)(sT + lr * 264 + 128 + f4), g2 = *(const bf16x4*)(sT + (lr + 1) * 264 + 128 + f4);
          float w0[4] = {wa0.x, wa0.y, wa0.z, wa0.w}, w1[4] = {wa1.x, wa1.y, wa1.z, wa1.w}, w2[4] = {wa2.x, wa2.y, wa2.z, wa2.w};
          float v0[4] = {wg0.x, wg0.y, wg0.z, wg0.w}, v1[4] = {wg1.x, wg1.y, wg1.z, wg1.w}, v2[4] = {wg2.x, wg2.y, wg2.z, wg2.w};
          float bb[4] = {ba.x, ba.y, ba.z, ba.w}, bgv[4] = {bg.x, bg.y, bg.z, bg.w};
          bf16x4 o;
#pragma unroll
          for (int e = 0; e < 4; ++e) {
            float av = bf2f((u16)a1[e]) * w1[e] + bb[e] + mp * bf2f((u16)a0[e]) * w0[e] + mn * bf2f((u16)a2[e]) * w2[e];
            float gv = bf2f((u16)g1[e]) * v1[e] + bgv[e] + mp * bf2f((u16)g0[e]) * v0[e] + mn * bf2f((u16)g2[e]) * v2[e];
            o[e] = (short)f2bf(av * siluf_(gv));
          }
          *(bf16x4*)(p.act + (size_t)row * F_ + fg) = o;
        }
      }
    }
    __syncthreads();
    return;
  }
#define EPI_LOOP(...) \
  _Pragma("unroll") for (int i = 0; i < 8; ++i) { \
    const int row = m0 + wm * 128 + 16 * i + l15; \
    _Pragma("unroll") for (int j = 0; j < 4; ++j) { \
      const int col = n0 + wn * 64 + 16 * j + 4 * lg; \
      f32x4 v = acc[i][j]; \
      __VA_ARGS__ \
      asm volatile("" ::: "memory"); \
    } }
  switch (g.mode) {
    case E_GLU: {
      float4 gtg[2];
      {
        const float* gate = p.mod + (size_t)(g.layer * 9 + brow_of(m0)) * 6144 + (3 * g.set + 2) * 1024;
#pragma unroll
        for (int j = 0; j < 2; ++j) {
          float4 c = *(const float4*)(gate + tn * 128 + 32 * wn + 16 * j + 4 * lg);
          gtg[j] = make_float4(c.x * g.scale, c.y * g.scale, c.z * g.scale, c.w * g.scale);
        }
      }
#pragma unroll
      for (int i4 = 0; i4 < 8; i4 += 2) {
        float4 xv[2][2];
#pragma unroll
        for (int ii = 0; ii < 2; ++ii) {
          const int row = m0 + wm * 128 + 16 * (i4 + ii) + l15;
#pragma unroll
          for (int j = 0; j < 2; ++j) xv[ii][j] = *(const float4*)(p.X + (size_t)row * D_ + tn * 128 + 32 * wn + 16 * j + 4 * lg);
        }
#pragma unroll
        for (int ii = 0; ii < 2; ++ii) {
          const int row = m0 + wm * 128 + 16 * (i4 + ii) + l15;
#pragma unroll
          for (int j = 0; j < 2; ++j) {
            f32x4 a = acc[i4 + ii][j], gg = acc[i4 + ii][j + 2];
            float4 x = xv[ii][j], gt = gtg[j];
            x.x += gt.x * a[0] * sigmoidf_(gg[0]); x.y += gt.y * a[1] * sigmoidf_(gg[1]);
            x.z += gt.z * a[2] * sigmoidf_(gg[2]); x.w += gt.w * a[3] * sigmoidf_(gg[3]);
            *(float4*)(p.X + (size_t)row * D_ + tn * 128 + 32 * wn + 16 * j + 4 * lg) = x;
          }
        }
        asm volatile("" ::: "memory");
      }
    } break;
    case E_LAT: {
      EPI_LOOP(if (col < 672) *(float4*)((float*)g.o0 + (size_t)row * 672 + col) = make_float4(v[0], v[1], v[2], v[3]);)
    } break;
    case E_PART: {
      EPI_LOOP(*(float4*)((float*)g.o0 + (size_t)(row - g.orb) * 1024 + col) = make_float4(v[0], v[1], v[2], v[3]);)
    } break;
    case E_F32: {
      EPI_LOOP(*(float4*)((float*)g.o0 + (size_t)(row - g.orb) * g.ldo + col) = make_float4(v[0], v[1], v[2], v[3]);)
    } break;
    case E_BF16: {
      EPI_LOOP(bf16x4 o; o[0] = (short)f2bf(v[0]); o[1] = (short)f2bf(v[1]); o[2] = (short)f2bf(v[2]); o[3] = (short)f2bf(v[3]);
               *(bf16x4*)((u16*)g.o0 + (size_t)(row - g.orb) * g.ldo + col) = o;)
    } break;
    case E_KV: {
      EPI_LOOP(int head = col >> 7; int w = col & 127;
               bf16x4 o; o[0] = (short)f2bf(v[0]); o[1] = (short)f2bf(v[1]); o[2] = (short)f2bf(v[2]); o[3] = (short)f2bf(v[3]);
               u16* dst = (w < 64) ? ((u16*)g.o0 + (size_t)row * 1024 + head * 64 + w) : ((u16*)g.o1 + (size_t)row * 1024 + head * 64 + (w - 64));
               *(bf16x4*)dst = o;)
    } break;
    case E_RES: {
      float4 gtr[4];
      {
        const float* gate = p.mod + (size_t)(g.layer * 9 + brow_of(m0)) * 6144 + (3 * g.set + 2) * 1024;
#pragma unroll
        for (int j = 0; j < 4; ++j) {
          float4 c = *(const float4*)(gate + n0 + wn * 64 + 16 * j + 4 * lg);
          gtr[j] = make_float4(c.x * g.scale, c.y * g.scale, c.z * g.scale, c.w * g.scale);
        }
      }
      const bool first = (g.layer == 0 && g.set == 0);
#pragma unroll
      for (int i2 = 0; i2 < 8; i2 += 2) {
        float4 xv[2][4];
#pragma unroll
        for (int ii = 0; ii < 2; ++ii) {
          const int row = m0 + wm * 128 + 16 * (i2 + ii) + l15;
          const float* xr = first ? in_row(p, row) : (p.X + (size_t)row * D_);
#pragma unroll
          for (int j = 0; j < 4; ++j) xv[ii][j] = *(const float4*)(xr + n0 + wn * 64 + 16 * j + 4 * lg);
        }
#pragma unroll
        for (int ii = 0; ii < 2; ++ii) {
          const int row = m0 + wm * 128 + 16 * (i2 + ii) + l15;
#pragma unroll
          for (int j = 0; j < 4; ++j) {
            f32x4 v = acc[i2 + ii][j];
            float4 x = xv[ii][j], gt = gtr[j];
            x.x += gt.x * v[0]; x.y += gt.y * v[1]; x.z += gt.z * v[2]; x.w += gt.w * v[3];
            *(float4*)(p.X + (size_t)row * D_ + n0 + wn * 64 + 16 * j + 4 * lg) = x;
          }
        }
        asm volatile("" ::: "memory");
      }
    } break;
    case E_HG: {
      float4 lbh[4];
#pragma unroll
      for (int j = 0; j < 4; ++j) lbh[j] = *(const float4*)(p.lb2 + ((n0 + wn * 64 + 16 * j + 4 * lg) & 1023));
      EPI_LOOP(int part = col >> 10; int c = col & 1023;
               size_t rl = (size_t)(row - g.orb);
               bf16x4 o;
               if (part == 0) {
                 _Pragma("unroll") for (int e = 0; e < 4; ++e) o[e] = (short)f2bf(siluf_(v[e]) * 0.08838834764831845f);
                 *(bf16x4*)(p.hq + rl * 1024 + c) = o;
               } else if (part <= 2) {
                 float4 lb = lbh[j];
                 float lbv[4] = {lb.x, lb.y, lb.z, lb.w};
                 _Pragma("unroll") for (int e = 0; e < 4; ++e) { float f = lbv[e] + (1.f - lbv[e]) * sigmoidf_(v[e]); o[e] = (short)__half_as_ushort(__float2half(__logf(f))); }
                 *(bf16x4*)(p.hlf + (size_t)(part - 1) * HR * 1024 + rl * 1024 + c) = o;
               } else if (part == 3) {
                 _Pragma("unroll") for (int e = 0; e < 4; ++e) o[e] = (short)f2bf(v[e]);
                 *(bf16x4*)(p.hv + rl * 1024 + c) = o;
               } else {
                 _Pragma("unroll") for (int e = 0; e < 4; ++e) o[e] = (short)f2bf(siluf_(v[e]));
                 *(bf16x4*)(p.hsg + rl * 1024 + c) = o;
               })
    } break;
    default: break;
  }
#undef EPI_LOOP
}

__device__ __forceinline__ void latnorm_phase(const Params& p) {
  int lane = tidx() & 63, wv = tidx() >> 6;
  const float* gq = p.in[9]; const float* gkv = p.in[11];
  for (int row = bidx() * 8 + wv; row < T_; row += gridDim.x * 8) {
    const float* l = p.lat + (size_t)row * 672;
    float q[6]; float ss = 0.f;
#pragma unroll
    for (int i = 0; i < 6; ++i) { q[i] = l[i * 64 + lane]; ss += q[i] * q[i]; }
    ss = wave_sum(ss);
    float rq = rsqrtf(ss * (1.f / 384.f) + EPS);
#pragma unroll
    for (int i = 0; i < 6; ++i) p.qn[(size_t)row * 384 + i * 64 + lane] = f2bf(q[i] * rq * gq[i * 64 + lane]);
    float k[4]; ss = 0.f;
#pragma unroll
    for (int i = 0; i < 4; ++i) { k[i] = l[384 + i * 64 + lane]; ss += k[i] * k[i]; }
    ss = wave_sum(ss);
    float rk = rsqrtf(ss * (1.f / 256.f) + EPS);
#pragma unroll
    for (int i = 0; i < 4; ++i) p.kvn[(size_t)row * 256 + i * 64 + lane] = f2bf(k[i] * rk * gkv[i * 64 + lane]);
    int b = row / PB, pp = row - b * PB;
    float v = (lane < 32) ? l[640 + lane] : 0.f;
    int jj = lane & 15;
    float vp = __shfl_xor(v, 8);
    float o = v;
    if (pp >= CTX) {
      int t = pp - CTX;
      int sec = (lane >> 4) & 1;
      int pos = sec == 0 ? (t >> 6) : (t & 63);
      int j = jj & 7;
      float c = p.cs[(pos * 8 + j) * 2], s = p.cs[(pos * 8 + j) * 2 + 1];
      o = (jj < 8) ? (v * c - vp * s) : (vp * s + v * c);
    }
    if (lane < 32) p.kr[(size_t)row * 32 + lane] = f2bf(o);
  }
}

template <int DK, int U, int MODE, int NW, int SUB>
__device__ __forceinline__ void attn_item(const Params& p, int item, u16* smem) {
  constexpr int NT = 64 * NW, KT = 64 * SUB;
  constexpr int KLD = DK + 8, VLD = 72, KS = DK / 32;
  const int tid = (NW == 8) ? tidx() : vtid(), lane = tid & 63, wv = tid >> 6;
  const int l15 = lane & 15, lg = lane >> 4;
  u16* sK = smem;
  u16* sV = smem + 2 * KT * KLD;
  float* sBias = (float*)(smem + 2 * KT * KLD + 2 * KT * VLD);
  int b, h, qrow0, nt, r = 0, r0 = 0, rq = 0, r0q = 0;
  constexpr int NLOC = (MODE == 2 && U == 2) ? 9 : 8;
  if (MODE == 0 && NW == 8) { int qb = item & 15; h = (item >> 4) & 15; b = item >> 8; qrow0 = b * PB + CTX + qb * 256 + wv * 32; nt = 68 / SUB; }
  else if (MODE == 1 && NW == 8) { h = item & 15; b = item >> 4; qrow0 = b * PB + wv * 32; nt = 4 / SUB; }
  else if (MODE == 0) { int qb = item & 31; h = (item >> 5) & 15; b = item >> 9; qrow0 = b * PB + CTX + qb * 128 + wv * 32; nt = 68; }
  else if (MODE == 1) { int qb = item & 1; h = (item >> 1) & 15; b = item >> 5; qrow0 = b * PB + qb * 128 + wv * 32; nt = 4; }
  else if (MODE == 2 && U == 2) {
    r = 2 * (item & 31); h = (item >> 5) & 15; b = item >> 9;
    rq = r + (wv >> 1); qrow0 = b * PB + CTX + rq * 64 + (wv & 1) * 32; nt = 13;
    r0 = min(max(r - 4, 0), 56); r0q = min(max(rq - 4, 0), 56);
  }
  else if (MODE == 2) { r = item & 63; h = (item >> 6) & 15; b = item >> 10; qrow0 = b * PB + CTX + r * 64 + wv * 16; nt = 12; r0 = min(max(r - 4, 0), 56); rq = r; r0q = r0; }
  else { int qb = item & 3; h = (item >> 2) & 15; b = item >> 6; qrow0 = b * PB + qb * 64 + wv * 16; nt = 4; }
  const float cscale = (MODE <= 1 ? 0.10206207261596577f : 0.125f) * LOG2E;

  bf16x8 qf[U][KS];
#pragma unroll
  for (int u = 0; u < U; ++u) {
    int qrow = qrow0 + 16 * u + l15;
    const u16* qp = (MODE <= 1) ? (p.Qm + (size_t)qrow * 1536 + h * 96) : (p.QKV + (size_t)qrow * 3072 + h * 64);
#pragma unroll
    for (int ks = 0; ks < KS; ++ks) qf[u][ks] = *(const bf16x8*)(qp + ks * 32 + lg * 8);
    if (MODE == 0) {
      int t = qrow - b * PB - CTX;
      int sec = lg >> 1;
      int pos = sec == 0 ? (t >> 6) : (t & 63);
      bf16x8 o;
#pragma unroll
      for (int j = 0; j < 8; ++j) {
        float v = bf2f((u16)qf[u][2][j]);
        float vp = __shfl_xor(v, 16);
        float c = p.cs[(pos * 8 + j) * 2], s = p.cs[(pos * 8 + j) * 2 + 1];
        float ov = ((lg & 1) == 0) ? (v * c - vp * s) : (vp * s + v * c);
        o[j] = (short)f2bf(ov);
      }
      qf[u][2] = o;
    }
  }
  float mrun[U], lsum[U];
  f32x4 oacc[4][U];
#pragma unroll
  for (int u = 0; u < U; ++u) {
    mrun[u] = -1e30f; lsum[u] = 0.f;
#pragma unroll
    for (int d = 0; d < 4; ++d) oacc[d][u] = (f32x4){0.f, 0.f, 0.f, 0.f};
  }
  bf16x8 rk[2], rkr, rv[2];
  auto krow_of = [&](int kt) -> int {
    if (MODE == 0) return b * PB + kt * KT;
    if (MODE == 2) return kt < NLOC ? (b * PB + CTX + min(r0 + kt, 63) * 64) : (b * PB + (kt - NLOC) * 64);
    return b * PB + kt * KT;
  };
  auto gload = [&](int kt) {
    int kr0 = krow_of(kt);
#pragma unroll
    for (int i = 0; i < 2; ++i) {
      int id = tid + NT * i; int key = id >> 3, c = id & 7;
      if (MODE <= 1) {
        rk[i] = *(const bf16x8*)(p.Kn + (size_t)(kr0 + key) * 1024 + h * 64 + c * 8);
        rv[i] = *(const bf16x8*)(p.Vm + (size_t)(kr0 + key) * 1024 + h * 64 + c * 8);
      } else {
        rk[i] = *(const bf16x8*)(p.QKV + (size_t)(kr0 + key) * 3072 + 1024 + h * 64 + c * 8);
        rv[i] = *(const bf16x8*)(p.QKV + (size_t)(kr0 + key) * 3072 + 2048 + h * 64 + c * 8);
      }
    }
    if (MODE <= 1) { int key = tid >> 2, c = tid & 3; rkr = *(const bf16x8*)(p.kr + (size_t)(kr0 + key) * 32 + c * 8); }
  };
  auto lstore = [&](int buf) {
#pragma unroll
    for (int i = 0; i < 2; ++i) {
      int id = tid + NT * i; int key = id >> 3, c = id & 7;
      *(bf16x8*)(sK + (buf * KT + key) * KLD + c * 8) = rk[i];
      *(bf16x8*)(sV + (buf * KT + key) * VLD + c * 8) = rv[i];
    }
    if (MODE <= 1) { int key = tid >> 2, c = tid & 3; *(bf16x8*)(sK + (buf * KT + key) * KLD + 64 + c * 8) = rkr; }
  };
  gload(0); lstore(0);
  if (MODE == 2) { for (int e = tid; e < 465; e += NT) sBias[e] = p.in[29][h * 465 + e] * LOG2E; }
  __syncthreads();
  for (int kt = 0; kt < nt; ++kt) {
    const int buf = kt & 1;
    if (kt + 1 < nt) gload(kt + 1);
#pragma unroll
    for (int sub = 0; sub < SUB; ++sub) {
    f32x4 sacc[4][U];
#pragma unroll
    for (int ms = 0; ms < 4; ++ms)
#pragma unroll
      for (int u = 0; u < U; ++u) sacc[ms][u] = (f32x4){0.f, 0.f, 0.f, 0.f};
    const bool local_tile = (MODE == 2) && (kt < NLOC);
    if (MODE == 2 && local_tile && (unsigned)((r0 + kt) - r0q) >= 8u) continue;
    const int mlo = (MODE == 2 && U == 1 && local_tile) ? ((wv <= 1) ? 0 : wv - 1) : 0;
    const int mhi = (MODE == 2 && U == 1 && local_tile) ? ((wv >= 2) ? 3 : wv + 1) : 3;
    if (MODE <= 1) {
#pragma unroll
      for (int hf = 0; hf < 2; ++hf) {
        bf16x8 kf[2][KS];
#pragma unroll
        for (int m2 = 0; m2 < 2; ++m2)
#pragma unroll
          for (int ks = 0; ks < KS; ++ks)
            kf[m2][ks] = *(const bf16x8*)(sK + (buf * KT + sub * 64 + 16 * (2 * hf + m2) + l15) * KLD + ks * 32 + lg * 8);
        __builtin_amdgcn_sched_barrier(0);
        __builtin_amdgcn_s_setprio(1);
#pragma unroll
        for (int m2 = 0; m2 < 2; ++m2)
#pragma unroll
          for (int ks = 0; ks < KS; ++ks)
#pragma unroll
            for (int u = 0; u < U; ++u)
              sacc[2 * hf + m2][u] = __builtin_amdgcn_mfma_f32_16x16x32_bf16(kf[m2][ks], qf[u][ks], sacc[2 * hf + m2][u], 0, 0, 0);
        __builtin_amdgcn_s_setprio(0);
        __builtin_amdgcn_sched_barrier(0);
      }
    } else {
      bf16x8 kf[4][KS];
#pragma unroll
      for (int ms = 0; ms < 4; ++ms)
#pragma unroll
        for (int ks = 0; ks < KS; ++ks)
          kf[ms][ks] = *(const bf16x8*)(sK + (buf * KT + sub * 64 + 16 * ms + l15) * KLD + ks * 32 + lg * 8);
      __builtin_amdgcn_sched_barrier(0);
#pragma unroll
      for (int ms = 0; ms < 4; ++ms) {
        if (MODE == 2 && (ms < mlo || ms > mhi)) continue;
#pragma unroll
        for (int ks = 0; ks < KS; ++ks)
#pragma unroll
          for (int u = 0; u < U; ++u) sacc[ms][u] = __builtin_amdgcn_mfma_f32_16x16x32_bf16(kf[ms][ks], qf[u][ks], sacc[ms][u], 0, 0, 0);
      }
      __builtin_amdgcn_sched_barrier(0);
    }
    bf16x8 pf[U][2];
#pragma unroll
    for (int u = 0; u < U; ++u) {
      const float* brow = nullptr; int dlt = 0;
      if (MODE == 2) {
        int w = (U == 2) ? ((wv & 1) * 32 + 16 * u + l15) : (wv * 16 + l15);
        int cs0 = min(max(w - 8, 0), 48);
        dlt = 4 * lg - cs0;
        brow = sBias + ((r0 + kt) - rq + 7) * 31 + (4 * lg - w + 15);
      }
      float tmax = -1e30f;
      if (local_tile) {
#pragma unroll
        for (int ms = 0; ms < 4; ++ms) {
          if (ms < mlo || ms > mhi) continue;
#pragma unroll
          for (int rr = 0; rr < 4; ++rr) {
            bool ok = (unsigned)(16 * ms + rr + dlt) < 16u;
            float tv = ok ? __builtin_fmaf(sacc[ms][u][rr], cscale, brow[16 * ms + rr]) : -1e30f;
            sacc[ms][u][rr] = tv;
            tmax = vmax(tmax, tv);
          }
        }
      } else {
#pragma unroll
        for (int ms = 0; ms < 4; ++ms) {
          tmax = vmax3(tmax, sacc[ms][u][0], sacc[ms][u][1]);
          tmax = vmax3(tmax, sacc[ms][u][2], sacc[ms][u][3]);
        }
        tmax *= cscale;
      }
      tmax = vmax(tmax, __shfl_xor(tmax, 16));
      tmax = vmax(tmax, __shfl_xor(tmax, 32));
      if (__any(tmax > mrun[u] + 8.f)) {
        float mnew = vmax(mrun[u], tmax);
        float alpha = __builtin_amdgcn_exp2f(mrun[u] - mnew);
        mrun[u] = mnew;
        lsum[u] *= alpha;
#pragma unroll
        for (int d = 0; d < 4; ++d) { oacc[d][u][0] *= alpha; oacc[d][u][1] *= alpha; oacc[d][u][2] *= alpha; oacc[d][u][3] *= alpha; }
      }
      const float mr = mrun[u];
      float ps = 0.f;
      u32x4 pk[2];
#pragma unroll
      for (int ms = 0; ms < 4; ++ms) {
        if (MODE == 2 && (ms < mlo || ms > mhi)) { pk[ms >> 1][(ms & 1) * 2] = 0u; pk[ms >> 1][(ms & 1) * 2 + 1] = 0u; continue; }
        float pv[4];
#pragma unroll
        for (int rr = 0; rr < 4; ++rr) {
          float x = local_tile ? (sacc[ms][u][rr] - mr) : __builtin_fmaf(sacc[ms][u][rr], cscale, -mr);
          pv[rr] = __builtin_amdgcn_exp2f(x);
          ps += pv[rr];
        }
        pk[ms >> 1][(ms & 1) * 2] = pack_bf16(pv[0], pv[1]);
        pk[ms >> 1][(ms & 1) * 2 + 1] = pack_bf16(pv[2], pv[3]);
      }
      lsum[u] += ps;
      pf[u][0] = __builtin_bit_cast(bf16x8, pk[0]);
      pf[u][1] = __builtin_bit_cast(bf16x8, pk[1]);
    }
    if (MODE <= 1) {
#pragma unroll
      for (int hf = 0; hf < 2; ++hf) {
        bf16x8 vf[2][2];
#pragma unroll
        for (int d2 = 0; d2 < 2; ++d2)
#pragma unroll
          for (int kb = 0; kb < 2; ++kb) {
            const u16* vp = sV + (buf * KT + sub * 64 + 32 * kb + 4 * lg + (l15 >> 2)) * VLD + 16 * (2 * hf + d2) + 4 * (l15 & 3);
            bf16x4 a0 = __builtin_amdgcn_ds_read_tr16_b64_v4i16((__attribute__((address_space(3))) bf16x4*)vp);
            bf16x4 a1 = __builtin_amdgcn_ds_read_tr16_b64_v4i16((__attribute__((address_space(3))) bf16x4*)(vp + 16 * VLD));
            bf16x8 a;
            a[0] = a0[0]; a[1] = a0[1]; a[2] = a0[2]; a[3] = a0[3]; a[4] = a1[0]; a[5] = a1[1]; a[6] = a1[2]; a[7] = a1[3];
            vf[d2][kb] = a;
          }
        __builtin_amdgcn_sched_barrier(0);
        __builtin_amdgcn_s_setprio(1);
#pragma unroll
        for (int d2 = 0; d2 < 2; ++d2)
#pragma unroll
          for (int kb = 0; kb < 2; ++kb)
#pragma unroll
            for (int u = 0; u < U; ++u)
              oacc[2 * hf + d2][u] = __builtin_amdgcn_mfma_f32_16x16x32_bf16(vf[d2][kb], pf[u][kb], oacc[2 * hf + d2][u], 0, 0, 0);
        __builtin_amdgcn_s_setprio(0);
        __builtin_amdgcn_sched_barrier(0);
      }
    } else {
#pragma unroll
      for (int hf = 0; hf < 2; ++hf) {
        bf16x8 vf[2][2];
#pragma unroll
        for (int d2 = 0; d2 < 2; ++d2)
#pragma unroll
          for (int kb = 0; kb < 2; ++kb) {
            const u16* vp = sV + (buf * KT + sub * 64 + 32 * kb + 4 * lg + (l15 >> 2)) * VLD + 16 * (2 * hf + d2) + 4 * (l15 & 3);
            bf16x4 a0 = __builtin_amdgcn_ds_read_tr16_b64_v4i16((__attribute__((address_space(3))) bf16x4*)vp);
            bf16x4 a1 = __builtin_amdgcn_ds_read_tr16_b64_v4i16((__attribute__((address_space(3))) bf16x4*)(vp + 16 * VLD));
            bf16x8 a;
            a[0] = a0[0]; a[1] = a0[1]; a[2] = a0[2]; a[3] = a0[3]; a[4] = a1[0]; a[5] = a1[1]; a[6] = a1[2]; a[7] = a1[3];
            vf[d2][kb] = a;
          }
        __builtin_amdgcn_sched_barrier(0);
#pragma unroll
        for (int d2 = 0; d2 < 2; ++d2)
#pragma unroll
          for (int kb = 0; kb < 2; ++kb) {
            if (MODE == 2 && (2 * kb + 1 < mlo || 2 * kb > mhi)) continue;
#pragma unroll
            for (int u = 0; u < U; ++u)
              oacc[2 * hf + d2][u] = __builtin_amdgcn_mfma_f32_16x16x32_bf16(vf[d2][kb], pf[u][kb], oacc[2 * hf + d2][u], 0, 0, 0);
          }
        __builtin_amdgcn_sched_barrier(0);
      }
    }
    }
    if (kt + 1 < nt) lstore(buf ^ 1);
    __syncthreads();
  }
#pragma unroll
  for (int u = 0; u < U; ++u) {
    float l = lsum[u];
    l += __shfl_xor(l, 16); l += __shfl_xor(l, 32);
    float inv = 1.f / l;
    int qrow = qrow0 + 16 * u + l15;
#pragma unroll
    for (int d = 0; d < 4; ++d) {
      bf16x4 o;
#pragma unroll
      for (int e = 0; e < 4; ++e) o[e] = (short)f2bf(oacc[d][u][e] * inv);
      *(bf16x4*)(p.U + (size_t)qrow * D_ + h * 64 + 16 * d + 4 * lg) = o;
    }
  }
}

template <bool EMIT>
__device__ __forceinline__ void s5_scan_item(const Params& p, int item, float* smem) {
  const int tid = vtid(), lane = tid & 63, wv = tid >> 6;
  float* hs = smem + wv * 4640;
  float* Cs = hs + 2080;
  float* zs = Cs + 2304;
  int wi = item * 4 + wv;
  int c = wi % 68; int g = (wi / 68) & 31; int d = (wi / (68 * 32)) & 1; int b = wi / (68 * 64);
  int dg = d * 32 + g;
  int n = lane;
  float lr = p.lamb[(dg * 64 + n) * 2], li = p.lamb[(dg * 64 + n) * 2 + 1];
  float bbr[16], bbi[16];
#pragma unroll
  for (int cc = 0; cc < 16; ++cc) { bbr[cc] = p.bbar[((dg * 64 + n) * 16 + cc) * 2]; bbi[cc] = p.bbar[((dg * 64 + n) * 16 + cc) * 2 + 1]; }
  float hr = 0.f, hi = 0.f;
  u16* hsb = (u16*)hs;
  bf16x8 cfr[4];
  if (EMIT) {
    hr = p.chst[((size_t)wi * 64 + n) * 2]; hi = p.chst[((size_t)wi * 64 + n) * 2 + 1];
    const int ch = lane & 15, lg4 = lane >> 4;
#pragma unroll
    for (int ks = 0; ks < 4; ++ks) {
      float4 cr = *(const float4*)(p.in[20] + (dg * 16 + ch) * 64 + 16 * ks + 4 * lg4);
      float4 ci = *(const float4*)(p.in[21] + (dg * 16 + ch) * 64 + 16 * ks + 4 * lg4);
      u32x4 pk;
      pk[0] = pack_bf16(cr.x, -ci.x); pk[1] = pack_bf16(cr.y, -ci.y); pk[2] = pack_bf16(cr.z, -ci.z); pk[3] = pack_bf16(cr.w, -ci.w);
      cfr[ks] = __builtin_bit_cast(bf16x8, pk);
    }
  }
  for (int sc = 0; sc < 4; ++sc) {
    {
      int st = lane >> 2, q4 = lane & 3;
      int row = b * PB + pos_of(d, c * 64 + sc * 16 + st);
      float4 zv = *(const float4*)(p.z + (size_t)row * 512 + g * 16 + q4 * 4);
      *(float4*)(zs + st * 16 + q4 * 4) = zv;
    }
    __syncthreads();
#pragma unroll 4
    for (int st = 0; st < 16; ++st) {
      float4 z0 = *(const float4*)(zs + st * 16), z1 = *(const float4*)(zs + st * 16 + 4);
      float4 z2 = *(const float4*)(zs + st * 16 + 8), z3 = *(const float4*)(zs + st * 16 + 12);
      float zz[16] = {z0.x, z0.y, z0.z, z0.w, z1.x, z1.y, z1.z, z1.w, z2.x, z2.y, z2.z, z2.w, z3.x, z3.y, z3.z, z3.w};
      float bur = 0.f, bui = 0.f;
#pragma unroll
      for (int cc = 0; cc < 16; ++cc) { bur += bbr[cc] * zz[cc]; bui += bbi[cc] * zz[cc]; }
      float nr = lr * hr - li * hi + bur;
      float ni = lr * hi + li * hr + bui;
      hr = nr; hi = ni;
      if (EMIT) { *(unsigned*)(hsb + st * 136 + 2 * n) = pack_bf16(hr, hi); }
    }
    __syncthreads();
    if (EMIT) {
      const int l15 = lane & 15, lg4 = lane >> 4;
      f32x4 ya = (f32x4){0.f, 0.f, 0.f, 0.f};
#pragma unroll
      for (int ks = 0; ks < 4; ++ks) {
        bf16x8 a = *(const bf16x8*)(hsb + l15 * 136 + 32 * ks + 8 * lg4);
        ya = __builtin_amdgcn_mfma_f32_16x16x32_bf16(a, cfr[ks], ya, 0, 0, 0);
      }
#pragma unroll
      for (int rr = 0; rr < 4; ++rr) {
        int row = b * PB + pos_of(d, c * 64 + sc * 16 + 4 * lg4 + rr);
        p.yd[((size_t)d * T_ + row) * 512 + g * 16 + l15] = ya[rr];
      }
      __syncthreads();
    }
  }
  if (!EMIT) { p.chst[((size_t)wi * 64 + n) * 2] = hr; p.chst[((size_t)wi * 64 + n) * 2 + 1] = hi; }
}

__device__ __forceinline__ void s5_combine_item(const Params& p, int item) {
  const int lane = tidx() & 63, wv = tidx() >> 6;
  int wi = item * 8 + wv;
  int g = wi & 31, d = (wi >> 5) & 1;
  int dg = d * 32 + g;
  float lr = p.lamb[(dg * 64 + lane) * 2], li = p.lamb[(dg * 64 + lane) * 2 + 1];
#pragma unroll
  for (int i = 0; i < 6; ++i) { float nr = lr * lr - li * li, ni = 2.f * lr * li; lr = nr; li = ni; }
  float Hr = 0.f, Hi = 0.f;
  for (int c = 0; c < 68; ++c) {
    size_t idx = (((size_t)wi * 68 + c) * 64 + lane) * 2;
    float a = p.chst[idx], bq = p.chst[idx + 1];
    p.chst[idx] = Hr; p.chst[idx + 1] = Hi;
    float nr = lr * Hr - li * Hi + a, ni = lr * Hi + li * Hr + bq;
    Hr = nr; Hi = ni;
  }
}

__device__ __forceinline__ void s5_gelu_phase(const Params& p) {
  const float* dsk = p.in[22];
  size_t total = (size_t)T_ * 512 / 4;
  for (size_t e = (size_t)bidx() * 512 + tidx(); e < total; e += (size_t)gridDim.x * 512) {
    size_t idx = e * 4; int c = (int)(idx & 511);
    float4 zv = *(const float4*)(p.z + idx), y0 = *(const float4*)(p.yd + idx), y1 = *(const float4*)(p.yd + (size_t)T_ * 512 + idx);
    float4 dv = *(const float4*)(dsk + c);
    bf16x4 o;
    o[0] = (short)f2bf(geluf_(zv.x * dv.x + y0.x + y1.x)); o[1] = (short)f2bf(geluf_(zv.y * dv.y + y0.y + y1.y));
    o[2] = (short)f2bf(geluf_(zv.z * dv.z + y0.z + y1.z)); o[3] = (short)f2bf(geluf_(zv.w * dv.w + y0.w + y1.w));
    *(bf16x4*)(p.U + idx) = o;
  }
}

__device__ __forceinline__ void hg_scan_item(const Params& p, int item, int half, u16* smem) {
  constexpr int QLD = 136, TLD = 72;
  const int tid = tidx(), lane = tid & 63, wv = tid >> 6;
  const bool mma = wv < 4;
  const int l15 = lane & 15, lg = lane >> 4;
  u16* sQ = smem;
  u16* sK = sQ + 64 * QLD;
  u16* sKT = sK + 64 * QLD;
  u16* sVt = sKT + 128 * TLD;
  u16* sST = sVt + 32 * TLD;
  float* sEb = (float*)(sST + 32 * QLD);
  int vs = item & 3, d = (item >> 2) & 1, h = (item >> 3) & 7, bl = item >> 6;
  const size_t rbase = (size_t)bl * PB;
  const u16* lfp = p.hlf + (size_t)d * HR * 1024;
  u16* op = p.ho + (size_t)d * HR * 1024;
  f32x4 Sacc[2][2];
#pragma unroll
  for (int a = 0; a < 2; ++a)
#pragma unroll
    for (int c = 0; c < 2; ++c) Sacc[a][c] = (f32x4){0.f, 0.f, 0.f, 0.f};
  for (int e = tid; e < 32 * QLD; e += 512) sST[e] = 0;
  __syncthreads();
  float* sTot = sEb + 128;
  u16* sLF = sK;
  bf16x8 rq[2], rlf[2], rvv;
  auto prefetch = [&](int ch) {
#pragma unroll
    for (int i = 0; i < 2; ++i) {
      int id = tid + 512 * i; int s = id >> 4, c = id & 15;
      size_t row = rbase + pos_of(d, ch * 64 + s);
      rq[i] = *(const bf16x8*)(p.hq + row * 1024 + h * 128 + c * 8);
      rlf[i] = *(const bf16x8*)(lfp + row * 1024 + h * 128 + c * 8);
    }
    if (tid < 256) {
      int s = tid >> 2, c = tid & 3;
      size_t row = rbase + pos_of(d, ch * 64 + s);
      rvv = *(const bf16x8*)(p.hv + row * 1024 + h * 128 + vs * 32 + c * 8);
    }
  };
  prefetch(0);
  for (int ch = 0; ch < 68; ++ch) {
#pragma unroll
    for (int i = 0; i < 2; ++i) {
      int id = tid + 512 * i; int s = id >> 4, c = id & 15;
      *(bf16x8*)(sQ + s * QLD + c * 8) = rq[i];
      *(bf16x8*)(sLF + s * QLD + c * 8) = rlf[i];
    }
    if (tid < 256) {
      int s = tid >> 2, c = tid & 3;
#pragma unroll
      for (int e = 0; e < 8; ++e) sVt[(c * 8 + e) * TLD + s] = (u16)rvv[e];
    }
    __syncthreads();
    if (ch + 1 < 68) prefetch(ch + 1);
    {
      const int j = tid & 127, sg = tid >> 7;
      float fv[16], pr[16];
      float run = 1.f;
#pragma unroll
      for (int e = 0; e < 16; ++e) {
        float lf = __half2float(__ushort_as_half(sLF[(16 * sg + e) * QLD + j]));
        fv[e] = __expf(lf);
        run *= fv[e];
        pr[e] = run;
      }
      sTot[sg * 128 + j] = run;
      __syncthreads();
      float p0 = sTot[j], p1 = sTot[128 + j], p2 = sTot[256 + j], p3 = sTot[384 + j];
      float scale = (sg == 0) ? 1.f : (sg == 1) ? p0 : (sg == 2) ? p0 * p1 : p0 * p1 * p2;
      if (sg == 0) sEb[j] = p0 * p1 * p2 * p3;
#pragma unroll
      for (int e8 = 0; e8 < 16; e8 += 8) {
        bf16x8 kt8;
#pragma unroll
        for (int e = 0; e < 8; ++e) {
          int s = 16 * sg + e8 + e;
          float eb = pr[e8 + e] * scale;
          float kin = (1.f - fv[e8 + e]) * __builtin_amdgcn_rcpf(eb);
          float qv = bf2f(sQ[s * QLD + j]);
          sQ[s * QLD + j] = f2bf(qv * eb);
          u16 kb = f2bf(kin);
          sK[s * QLD + j] = kb;
          kt8[e] = (short)kb;
        }
        *(bf16x8*)(sKT + j * TLD + 16 * sg + e8) = kt8;
      }
    }
    __syncthreads();
    if (mma) {
    bf16x8 qfr[4], kfr[2][4], vop[2][2], stf[2][4], ktf[2][2], vbf[2][2];
    f32x4 att[4];
#pragma unroll
    for (int ks = 0; ks < 4; ++ks) qfr[ks] = *(const bf16x8*)(sQ + (16 * wv + l15) * QLD + ks * 32 + lg * 8);
#pragma unroll
    for (int ms = 0; ms < 2; ++ms)
#pragma unroll
      for (int ks = 0; ks < 4; ++ks) kfr[ms][ks] = *(const bf16x8*)(sK + (16 * ms + l15) * QLD + ks * 32 + lg * 8);
#pragma unroll
    for (int md = 0; md < 2; ++md)
#pragma unroll
      for (int kb = 0; kb < 2; ++kb) ktf[md][kb] = *(const bf16x8*)(sKT + (32 * wv + 16 * md + l15) * TLD + kb * 32 + lg * 8);
#pragma unroll
    for (int nv = 0; nv < 2; ++nv)
#pragma unroll
      for (int kb = 0; kb < 2; ++kb) vbf[nv][kb] = *(const bf16x8*)(sVt + (16 * nv + l15) * TLD + kb * 32 + lg * 8);
    __builtin_amdgcn_sched_barrier(0);
#pragma unroll
    for (int ms = 0; ms < 2; ++ms) {
      att[ms] = (f32x4){0.f, 0.f, 0.f, 0.f};
#pragma unroll
      for (int ks = 0; ks < 4; ++ks) att[ms] = __builtin_amdgcn_mfma_f32_16x16x32_bf16(kfr[ms][ks], qfr[ks], att[ms], 0, 0, 0);
    }
#pragma unroll
    for (int md = 0; md < 2; ++md)
#pragma unroll
      for (int kb = 0; kb < 2; ++kb)
#pragma unroll
        for (int nv = 0; nv < 2; ++nv)
          Sacc[md][nv] = __builtin_amdgcn_mfma_f32_16x16x32_bf16(ktf[md][kb], vbf[nv][kb], Sacc[md][nv], 0, 0, 0);
    __builtin_amdgcn_sched_barrier(0);
#pragma unroll
    for (int ms = 0; ms < 2; ++ms)
#pragma unroll
      for (int ks = 0; ks < 4; ++ks) kfr[ms][ks] = *(const bf16x8*)(sK + (16 * (2 + ms) + l15) * QLD + ks * 32 + lg * 8);
#pragma unroll
    for (int nv = 0; nv < 2; ++nv) {
#pragma unroll
      for (int kb = 0; kb < 2; ++kb) {
        const u16* vp = sVt + (16 * nv + l15) * TLD + 32 * kb + 4 * lg;
        bf16x4 a0 = *(const bf16x4*)vp, a1 = *(const bf16x4*)(vp + 16);
        bf16x8 a;
        a[0] = a0[0]; a[1] = a0[1]; a[2] = a0[2]; a[3] = a0[3]; a[4] = a1[0]; a[5] = a1[1]; a[6] = a1[2]; a[7] = a1[3];
        vop[nv][kb] = a;
      }
#pragma unroll
      for (int ks = 0; ks < 4; ++ks) stf[nv][ks] = *(const bf16x8*)(sST + (16 * nv + l15) * QLD + ks * 32 + lg * 8);
    }
    __builtin_amdgcn_sched_barrier(0);
#pragma unroll
    for (int ms = 0; ms < 2; ++ms) {
      att[2 + ms] = (f32x4){0.f, 0.f, 0.f, 0.f};
#pragma unroll
      for (int ks = 0; ks < 4; ++ks) att[2 + ms] = __builtin_amdgcn_mfma_f32_16x16x32_bf16(kfr[ms][ks], qfr[ks], att[2 + ms], 0, 0, 0);
    }
    f32x4 oacc[2];
#pragma unroll
    for (int nv = 0; nv < 2; ++nv) {
      oacc[nv] = (f32x4){0.f, 0.f, 0.f, 0.f};
#pragma unroll
      for (int ks = 0; ks < 4; ++ks) oacc[nv] = __builtin_amdgcn_mfma_f32_16x16x32_bf16(stf[nv][ks], qfr[ks], oacc[nv], 0, 0, 0);
    }
    bf16x8 pfr[2];
    {
      int t = 16 * wv + l15;
#pragma unroll
      for (int ms = 0; ms < 4; ++ms)
#pragma unroll
        for (int rr = 0; rr < 4; ++rr) {
          int s = 16 * ms + 4 * lg + rr;
          float v = (s <= t) ? att[ms][rr] : 0.f;
          pfr[ms >> 1][(ms & 1) * 4 + rr] = (short)f2bf(v);
        }
    }
#pragma unroll
    for (int nv = 0; nv < 2; ++nv)
#pragma unroll
      for (int kb = 0; kb < 2; ++kb) oacc[nv] = __builtin_amdgcn_mfma_f32_16x16x32_bf16(vop[nv][kb], pfr[kb], oacc[nv], 0, 0, 0);
    {
      int t = 16 * wv + l15;
      size_t row = rbase + pos_of(d, ch * 64 + t);
#pragma unroll
      for (int nv = 0; nv < 2; ++nv) {
        bf16x4 o;
#pragma unroll
        for (int e = 0; e < 4; ++e) o[e] = (short)f2bf(oacc[nv][e]);
        *(bf16x4*)(op + row * 1024 + h * 128 + vs * 32 + 16 * nv + 4 * lg) = o;
      }
    }
    }
    __syncthreads();
    if (mma) {
#pragma unroll
    for (int md = 0; md < 2; ++md) {
      int d0 = 32 * wv + 16 * md + 4 * lg;
      float4 eb = *(const float4*)(sEb + d0);
#pragma unroll
      for (int nv = 0; nv < 2; ++nv) {
        Sacc[md][nv][0] *= eb.x; Sacc[md][nv][1] *= eb.y; Sacc[md][nv][2] *= eb.z; Sacc[md][nv][3] *= eb.w;
        bf16x4 o;
#pragma unroll
        for (int e = 0; e < 4; ++e) o[e] = (short)f2bf(Sacc[md][nv][e]);
        *(bf16x4*)(sST + (16 * nv + l15) * QLD + d0) = o;
      }
    }
    }
    __syncthreads();
  }
}

__device__ __forceinline__ void hg_readout_phase(const Params& p, int half) {
  int lane = tidx() & 63, wv = tidx() >> 6;
  const float* ng = p.in[26];
  for (int rl = bidx() * 8 + wv; rl < HR; rl += gridDim.x * 8) {
    size_t o = (size_t)rl * 1024 + lane * 16;
    bf16x8 a0 = *(const bf16x8*)(p.ho + o), a1 = *(const bf16x8*)(p.ho + o + 8);
    bf16x8 b0 = *(const bf16x8*)(p.ho + (size_t)HR * 1024 + o), b1 = *(const bf16x8*)(p.ho + (size_t)HR * 1024 + o + 8);
    bf16x8 g0 = *(const bf16x8*)(p.hsg + o), g1 = *(const bf16x8*)(p.hsg + o + 8);
    float v[16]; float ss = 0.f;
#pragma unroll
    for (int e = 0; e < 8; ++e) {
      v[e] = bf2f((u16)a0[e]) + bf2f((u16)b0[e]);
      v[8 + e] = bf2f((u16)a1[e]) + bf2f((u16)b1[e]);
    }
#pragma unroll
    for (int e = 0; e < 16; ++e) ss += v[e] * v[e];
    ss += __shfl_xor(ss, 1); ss += __shfl_xor(ss, 2); ss += __shfl_xor(ss, 4);
    float rstd = rsqrtf(ss * (1.f / 128.f) + EPS);
    bf16x8 o0, o1;
#pragma unroll
    for (int e = 0; e < 8; ++e) {
      o0[e] = (short)f2bf(v[e] * rstd * ng[lane * 16 + e] * bf2f((u16)g0[e]));
      o1[e] = (short)f2bf(v[8 + e] * rstd * ng[lane * 16 + 8 + e] * bf2f((u16)g1[e]));
    }
    size_t uo = ((size_t)half * HR + rl) * 1024 + lane * 16;
    *(bf16x8*)(p.U + uo) = o0; *(bf16x8*)(p.U + uo + 8) = o1;
  }
}

__device__ __forceinline__ void convgate_phase(const Params& p, int layer) {
  const float* cw = p.in[32] + (size_t)layer * 3 * F2;
  const float* cb = p.in[33] + (size_t)layer * F2;
  const size_t total = (size_t)HR * (F_ / 8);
  for (size_t e = (size_t)bidx() * 512 + tidx(); e < total; e += (size_t)gridDim.x * 512) {
    int rl = (int)(e / (F_ / 8)); int f = (int)(e % (F_ / 8)) * 8;
    int pp = rl % PB;
    bool hasp = (pp != 0) && (pp != CTX);
    bool hasn = (pp != CTX - 1) && (pp != PB - 1);
    const u16* hrow = p.H + (size_t)rl * F2;
    float a[8], gq[8];
#pragma unroll
    for (int part = 0; part < 2; ++part) {
      int fo = f + part * F_;
      bf16x8 c1 = *(const bf16x8*)(hrow + fo);
      bf16x8 c0 = c1, c2 = c1;
      if (hasp) c0 = *(const bf16x8*)(hrow - F2 + fo);
      if (hasn) c2 = *(const bf16x8*)(hrow + F2 + fo);
      float* dst = part == 0 ? a : gq;
#pragma unroll
      for (int k = 0; k < 8; ++k) {
        float v = bf2f((u16)c1[k]) * cw[F2 + fo + k] + cb[fo + k];
        if (hasp) v += bf2f((u16)c0[k]) * cw[fo + k];
        if (hasn) v += bf2f((u16)c2[k]) * cw[2 * F2 + fo + k];
        dst[k] = v;
      }
    }
    bf16x8 o;
#pragma unroll
    for (int k = 0; k < 8; ++k) o[k] = (short)f2bf(a[k] * siluf_(gq[k]));
    *(bf16x8*)(p.act + (size_t)rl * F_ + f) = o;
  }
}

constexpr int SMEM_BYTES = 74240;
enum { T_PREP = 0, T_NORM, T_GEMM, T_LATNORM, T_ATTN_MLA, T_S5A, T_S5B, T_S5C, T_S5GELU, T_HGSCAN, T_HGRO, T_ATTN_NA, T_CONVGATE, T_FINAL, T_NONE };
struct PD { int type, layer, set, half; GA g, g2; };

__device__ __forceinline__ void get_phase(const Params& p, int target, PD& pd) {
  int ph = 0;
  pd.type = T_NONE; pd.layer = 0; pd.set = 0; pd.half = 0;
  pd.g = GA{}; pd.g2 = GA{};
#define AT(code) { if (ph == target) { code } ++ph; }
  AT(pd.type = T_PREP;)
  for (int layer = 0; layer < 4; ++layer) {
    AT(pd.type = T_NORM; pd.layer = layer; pd.set = 0;)
    if (layer == 0) {
      AT(pd.type = T_GEMM; GA& g = pd.g; g.A = p.U; g.lda = 1024; g.Bt = p.w_mla_in; g.K = 1024; g.mt = T_ / 256; g.nt = 3; g.mode = E_LAT; g.o0 = p.lat;)
      AT(pd.type = T_LATNORM;)
      AT(pd.type = T_GEMM; GA& g = pd.g; g.A = p.qn; g.lda = 384; g.Bt = p.w_mla_q; g.K = 384; g.mt = T_ / 256; g.nt = 6; g.mode = E_BF16; g.o0 = p.Qm; g.ldo = 1536;
         GA& g2 = pd.g2; g2.A = p.kvn; g2.lda = 256; g2.Bt = p.w_mla_kv; g2.K = 256; g2.mt = T_ / 256; g2.nt = 8; g2.mode = E_KV; g2.o0 = p.Kn; g2.o1 = p.Vm;)
      AT(pd.type = T_ATTN_MLA;)
      AT(pd.type = T_GEMM; GA& g = pd.g; g.A = p.U; g.lda = 1024; g.Bt = p.w_mla_out; g.K = 1024; g.mt = T_ / 256; g.nt = 4; g.mode = E_RES; g.layer = 0; g.set = 0;)
    } else if (layer == 1) {
      AT(pd.type = T_GEMM; GA& g = pd.g; g.A = p.U; g.lda = 1024; g.Bt = p.w_s5_in; g.K = 1024; g.mt = T_ / 256; g.nt = 2; g.mode = E_F32; g.o0 = p.z; g.ldo = 512;)
      AT(pd.type = T_S5A;)
      AT(pd.type = T_S5B;)
      AT(pd.type = T_S5C;)
      AT(pd.type = T_S5GELU;)
      AT(pd.type = T_GEMM; GA& g = pd.g; g.A = p.U; g.lda = 512; g.Bt = p.w_s5_glu; g.K = 512; g.mt = T_ / 256; g.nt = 8; g.mode = E_GLU; g.layer = 1; g.set = 0;)
    } else if (layer == 2) {
      for (int half = 0; half < 2; ++half) {
        AT(pd.type = T_GEMM; GA& g = pd.g; g.A = p.U; g.lda = 1024; g.Bt = p.w_hg_in; g.K = 1024; g.row0 = half * HR; g.mt = HR / 256; g.nt = 20; g.mode = E_HG; g.orb = half * HR;)
        AT(pd.type = T_HGSCAN; pd.half = half;)
        AT(pd.type = T_HGRO; pd.half = half;)
      }
      AT(pd.type = T_GEMM; GA& g = pd.g; g.A = p.U; g.lda = 1024; g.Bt = p.w_hg_out; g.K = 1024; g.mt = T_ / 256; g.nt = 4; g.mode = E_RES; g.layer = 2; g.set = 0;)
    } else {
      AT(pd.type = T_GEMM; GA& g = pd.g; g.A = p.U; g.lda = 1024; g.Bt = p.w_na_qkv; g.K = 1024; g.mt = T_ / 256; g.nt = 12; g.mode = E_BF16; g.o0 = p.QKV; g.ldo = 3072;)
      AT(pd.type = T_ATTN_NA;)
      AT(pd.type = T_GEMM; GA& g = pd.g; g.A = p.U; g.lda = 1024; g.Bt = p.w_na_out; g.K = 1024; g.mt = T_ / 256; g.nt = 4; g.mode = E_RES; g.layer = 3; g.set = 0;)
    }
    AT(pd.type = T_NORM; pd.layer = layer; pd.set = 1;)
    AT(pd.type = T_GEMM; GA& g = pd.g; g.A = p.U; g.lda = 1024; g.Bt = p.w_up[layer]; g.K = 1024; g.mt = 138; g.nt = 22; g.mode = E_FFNUP; g.layer = layer;)
    AT(pd.type = T_GEMM; GA& g = pd.g; g.A = p.act; g.lda = F_; g.Bt = p.w_down[layer]; g.K = F_; g.mt = T_ / 256; g.nt = 4; g.mode = E_RES; g.layer = layer; g.set = 1;)
  }
  AT(pd.type = T_FINAL;)
#undef AT
}


#define XB_TMO      128
#define XB_XCNT(j)  (256  + 64 * (j))
#define XB_XSUB(j)  (1280 + 64 * (j))
#define XB_XGEN(j)  (2304 + 64 * (j))
#define XB_TOP      3328
#define XB_TOPGEN   3392
#define XCD_BAR_WORDS 3456
#define XB_SPIN_CAP (1u << 23)
#define LAS __attribute__((address_space(3)))
__device__ __forceinline__ unsigned xb_ld(unsigned* p) { return __hip_atomic_load(p, __ATOMIC_RELAXED, __HIP_MEMORY_SCOPE_AGENT); }
__device__ __forceinline__ unsigned xb_add(unsigned* p, unsigned v) { return __hip_atomic_fetch_add(p, v, __ATOMIC_RELAXED, __HIP_MEMORY_SCOPE_AGENT); }
__device__ __forceinline__ unsigned xb_xcc_id() { return (unsigned)__builtin_amdgcn_s_getreg((3 << 11) | 20) & 0xFu; }
#define XB_SPIN(cond, bar) do { unsigned _sp = 0; while (cond) { __builtin_amdgcn_s_sleep(1); \
    if ((++_sp & 255u) == 0u) { if (xb_ld(&(bar)[XB_TMO])) break; if (_sp > XB_SPIN_CAP) { atomicAdd(&(bar)[XB_TMO], 1u); break; } } } } while (0)
struct XcdBarrier { unsigned* bar; unsigned x; volatile LAS unsigned* st; };
__device__ __forceinline__ XcdBarrier xcd_barrier_post(unsigned* bar, volatile LAS unsigned* st) {
  XcdBarrier b; b.bar = bar; b.x = xb_xcc_id(); b.st = st;
  if (threadIdx.x == 0) (void)xb_add(&bar[XB_XCNT(b.x)], 1u);
  return b;
}
__device__ __forceinline__ void xcd_barrier_complete(unsigned* bar, unsigned x, unsigned& nloc, unsigned& nx) {
  const unsigned G = gridDim.x * gridDim.y * gridDim.z;
  unsigned sum, cnt, mine, sp = 0u;
  for (;;) {
    sum = 0u; cnt = 0u; mine = 0u;
#pragma unroll
    for (unsigned j = 0; j < 16; ++j) { const unsigned c = xb_ld(&bar[XB_XCNT(j)]); sum += c; cnt += (c > 0u) ? 1u : 0u; mine = (j == x) ? c : mine; }
    if (sum == G) break;
    __builtin_amdgcn_s_sleep(1);
    if ((++sp & 255u) == 0u) { if (xb_ld(&bar[XB_TMO])) break; if (sp > XB_SPIN_CAP) { atomicAdd(&bar[XB_TMO], 1u); break; } }
  }
  nloc = mine > 0u ? mine : 1u; nx = cnt > 0u ? cnt : 1u;
}
__device__ __forceinline__ void xcd_barrier(const XcdBarrier& b) {
  asm volatile("s_waitcnt vmcnt(0)" ::: "memory");
  __syncthreads();
  if (threadIdx.x == 0) {
    unsigned* bar = b.bar;
    __builtin_amdgcn_s_waitcnt(0);
    unsigned nloc = b.st[0], nx = b.st[1];
    if (nloc == 0u) { xcd_barrier_complete(bar, b.x, nloc, nx); b.st[0] = nloc; b.st[1] = nx; }
    const unsigned old = xb_add(&bar[XB_XSUB(b.x)], 1u);
    const unsigned gen = old / nloc;
    if (old + 1u == (gen + 1u) * nloc) {
      __builtin_amdgcn_fence(__ATOMIC_RELEASE, "agent");
      asm volatile("s_waitcnt vmcnt(0)" ::: "memory");
      const unsigned og = xb_add(&bar[XB_TOP], 1u);
      const unsigned tg = og / nx;
      if (og + 1u == (tg + 1u) * nx) xb_add(&bar[XB_TOPGEN], 1u);
      else XB_SPIN(xb_ld(&bar[XB_TOPGEN]) == tg, bar);
      __builtin_amdgcn_fence(__ATOMIC_ACQUIRE, "agent");
      xb_add(&bar[XB_XGEN(b.x)], 1u);
      asm volatile("s_waitcnt vmcnt(0)" ::: "memory");
    } else {
      XB_SPIN(xb_ld(&bar[XB_XGEN(b.x)]) == gen, bar);
      __builtin_amdgcn_fence(__ATOMIC_ACQUIRE, "agent");
      asm volatile("s_waitcnt vmcnt(0)" ::: "memory");
    }
  }
  __syncthreads();
}

constexpr int SMEM_HALF = 74240;
#define VLOOP(n, call, ndry) \
  for (int k_ = 0; k_ * VG < (n); ++k_) { int it = vbid + k_ * VG; \
    if (it < (n)) { call; } else { for (int q_ = 0; q_ < (ndry); ++q_) __syncthreads(); } }

__global__ void __launch_bounds__(512, 2) mega(Params p, int ph_lo, int ph_hi) {
  cg::grid_group grid = cg::this_grid();
  __shared__ __attribute__((aligned(16))) unsigned char smem_raw[2 * SMEM_HALF + 16];
  u16* smem = (u16*)smem_raw;
  const int G = gridDim.x, bid = bidx();
  volatile LAS unsigned* xst = (volatile LAS unsigned*)(smem_raw + 2 * SMEM_HALF);
  if (threadIdx.x == 0) { xst[0] = 0u; xst[1] = 0u; }
  __syncthreads();
  XcdBarrier xb = xcd_barrier_post(p.bar, xst);
  for (int ph = ph_lo; ph < ph_hi; ++ph) {
    if (ph > ph_lo) { if (ph == ph_lo + 1) grid.sync(); else xcd_barrier(xb); }
    PD pd;
    get_phase(p, ph, pd);
    pd.g.scale = 1.f; pd.g2.scale = 1.f;
    const int vh = tidx() >> 8;
    const int vbid = bid * 2 + vh, VG = 2 * G;
    u16* smh = (u16*)(smem_raw + vh * SMEM_HALF);
    float* smfh = (float*)smh;
#ifdef PROBE_MASK
    const int reps = ((PROBE_MASK >> pd.type) & 1) ? 2 : 1;
    for (int rep = 0; rep < reps; ++rep) {
    if (rep > 0) { grid.sync(); pd.g.scale = 0.f; pd.g2.scale = 0.f; }
#endif
    switch (pd.type) {
      case T_PREP: {
        VLOOP(p.ntt, prep_transpose(p, it, smfh), 2)
        VLOOP(384, prep_mod(p, it, smfh), 3)
        VLOOP(17, prep_small(p, it), 0)
      } break;
      case T_NORM: modnorm_phase(p, pd.layer, pd.set, pd.set == 0 ? p.in[6] : p.in[7], (G == 256 && pd.set == 0 && pd.layer > 0) ? pd.layer - 1 : -1); break;
      case T_GEMM: {
        int t1 = pd.g.mt * pd.g.nt, t2 = pd.g2.mt * pd.g2.nt;
        int nall = t1 + t2;
        const bool splitk = (pd.g.mode == E_RES) && (pd.g.K == F_) && (t1 == 544) && (t2 == 0) && (G == 256);
        if (splitk) nall = 512;
        int chunk = (nall + 7) >> 3;
        int xcd = bid & 7, bl = bid >> 3, gl = G >> 3;
        int vend = min((xcd + 1) * chunk, nall);
        for (int v = xcd * chunk + bl; v < vend; v += gl) {
          bool first = v < t1;
          GA cur = first ? pd.g : pd.g2;
          int vv = first ? v : v - t1;
          int per = 8 * cur.nt;
          int sr = vv / per, rem = vv - sr * per;
          int full = cur.mt >> 3;
          int tn, tm;
          if (sr < full) { tn = rem >> 3; tm = sr * 8 + (rem & 7); }
          else { int rl = cur.mt & 7; tn = rem / rl; tm = full * 8 + (rem - tn * rl); }
          gemm_tile(p, cur, tm, tn, smem);
        }
        if (splitk) {
          GA cur = pd.g;
          int tile = bid >> 3, c = bid & 7;
          int tn = tile >> 3, tm = 128 + (tile & 7);
          int nks = cur.K >> 6;
          cur.kb = (c * nks) >> 3; cur.ke = ((c + 1) * nks) >> 3;
          cur.mode = E_PART; cur.o0 = (cur.layer == 3 ? p.part3 : p.part0) + (size_t)c * 2048 * 1024; cur.orb = 32768;
          gemm_tile(p, cur, tm, tn, smem);
        }
      } break;
      case T_LATNORM: latnorm_phase(p); break;
      case T_ATTN_MLA: {
        if (G == 256) {
          const int x = bid & 7, bl = bid >> 3;
          for (int k = 0; k < 8; ++k) attn_item<96, 2, 0, 8, 2>(p, (k * 16 + x * 2 + (bl >> 4)) * 16 + (bl & 15), smem);
        } else {
          for (int it = bid; it < 2048; it += G) attn_item<96, 2, 0, 8, 2>(p, it, smem);
        }
        for (int it = bid; it < 128; it += G) attn_item<96, 2, 1, 8, 2>(p, it, smem);
      } break;
      case T_S5A: {
        if (G == 256) { const int x = bid & 7, vb = (bid >> 3) * 2 + vh; for (int k = 0; k < 17; ++k) s5_scan_item<false>(p, x * 1088 + vb + 64 * k, smfh); }
        else { VLOOP(8704, s5_scan_item<false>(p, it, smfh), 8) }
      } break;
      case T_S5B: for (int it = bid; it < 64; it += G) s5_combine_item(p, it); break;
      case T_S5C: {
        if (G == 256) { const int x = bid & 7, vb = (bid >> 3) * 2 + vh; for (int k = 0; k < 17; ++k) s5_scan_item<true>(p, x * 1088 + vb + 64 * k, smfh); }
        else { VLOOP(8704, s5_scan_item<true>(p, it, smfh), 12) }
      } break;
      case T_S5GELU: s5_gelu_phase(p); break;
      case T_HGSCAN: {
        for (int it = bid; it < 256; it += G) {
          const int itx = (G == 256) ? ((((it & 7) * 8 + (it >> 5)) << 2) | ((it >> 3) & 3)) : it;
          hg_scan_item(p, itx, pd.half, smem);
        }
      } break;
      case T_HGRO: hg_readout_phase(p, pd.half); break;
      case T_ATTN_NA: {
        if (G == 256) {
          const int x = bid & 7, vb = (bid >> 3) * 2 + vh;
          for (int k = 0; k < 8; ++k) attn_item<64, 2, 2, 4, 1>(p, (k * 16 + x * 2 + (vb >> 5)) * 32 + (vb & 31), smh);
        } else { VLOOP(4096, (attn_item<64, 2, 2, 4, 1>(p, it, smh)), 14) }
      } break;
      case T_FINAL: final_norm_phase(p, G == 256); break;
      default: break;
    }
#ifdef PROBE_MASK
    }
#endif
  }
}

constexpr int N_PHASES = 39;

extern "C" void kernel_launch(void* const* d_in, const int* in_sizes, int n_in, void* d_out, int out_size,
                              void* d_ws, size_t ws_size, hipStream_t stream) {
  Params p;
  memset(&p, 0, sizeof(p));
  for (int i = 0; i < 36; ++i) p.in[i] = (const float*)d_in[i];
  p.out = (float*)d_out;
  char* ws = (char*)d_ws;
  size_t off = 0;
  auto take = [&](size_t bytes) { char* r = ws + off; off += (bytes + 255) & ~(size_t)255; return r; };
  p.bar = (unsigned*)take(XCD_BAR_WORDS * 4);
  p.X = (float*)take((size_t)T_ * D_ * 4);
  p.U = (u16*)take((size_t)T_ * D_ * 2);
  p.mod = (float*)take((size_t)4 * 9 * 6144 * 4);
  p.cs = (float*)take(4096);
  p.lb2 = (float*)take(4096);
  p.lamb = (float*)take(2 * 32 * 64 * 2 * 4);
  p.bbar = (float*)take(2 * 32 * 64 * 16 * 2 * 4);
  int ntd = 0, ntt = 0;
  auto addw = [&](const float* src, int K, int N, int Npad, int mode) -> u16* {
    u16* dst = (u16*)take((size_t)Npad * K * 2);
    p.td[ntd].src = src; p.td[ntd].dst = dst; p.td[ntd].K = K; p.td[ntd].N = N; p.td[ntd].Npad = Npad; p.td[ntd].mode = mode;
    ntt += (K / 64) * (Npad / 64); ++ntd;
    return dst;
  };
  p.w_mla_in = addw(p.in[8], 1024, 672, 768, 0);
  p.w_mla_q = addw(p.in[10], 384, 1536, 1536, 0);
  p.w_mla_kv = addw(p.in[12], 256, 2048, 2048, 0);
  p.w_mla_out = addw(p.in[13], 1024, 1024, 1024, 0);
  p.w_s5_in = addw(p.in[14], 1024, 512, 512, 0);
  p.w_s5_glu = addw(p.in[23], 512, 2048, 2048, 1);
  p.w_hg_in = addw(p.in[24], 1024, 5120, 5120, 0);
  p.w_hg_out = addw(p.in[27], 1024, 1024, 1024, 0);
  p.w_na_qkv = addw(p.in[28], 1024, 3072, 3072, 0);
  p.w_na_out = addw(p.in[30], 1024, 1024, 1024, 0);
  for (int i = 0; i < 4; ++i) {
    p.w_up[i] = addw(p.in[31] + (size_t)i * 1024 * F2, 1024, F2, F2, 2);
    p.w_down[i] = addw(p.in[34] + (size_t)i * F_ * 1024, F_, 1024, 1024, 0);
  }
  p.ntd = ntd; p.ntt = ntt;
  char* S = ws + off;
  char* O2 = (char*)d_out;
  p.lat = (float*)S; p.Qm = (u16*)S; p.Kn = (u16*)(S + (size_t)T_ * 1536 * 2);
  p.Vm = (u16*)O2; p.qn = (u16*)(O2 + (size_t)T_ * 1024 * 2); p.kvn = p.qn + (size_t)T_ * 384; p.kr = p.kvn + (size_t)T_ * 256;
  p.z = (float*)S; p.yd = (float*)(S + (size_t)T_ * 512 * 4); p.chst = (float*)O2; p.part0 = (float*)O2; p.part3 = (float*)p.U;
  p.hq = (u16*)S; p.hlf = p.hq + (size_t)HR * 1024; p.hv = p.hlf + (size_t)2 * HR * 1024; p.hsg = p.hv + (size_t)HR * 1024; p.ho = (u16*)O2;
  p.QKV = (u16*)S;
  p.H = (u16*)S; p.act = (u16*)S;

  static int grid_blocks = 0;
  if (!grid_blocks) {
    int dev = 0, cus = 0, per_cu = 0;
    (void)hipGetDevice(&dev);
    (void)hipDeviceGetAttribute(&cus, hipDeviceAttributeMultiprocessorCount, dev);
    (void)hipOccupancyMaxActiveBlocksPerMultiprocessor(&per_cu, mega, 512, 0);
    if (per_cu < 1) per_cu = 1;
    if (per_cu > 1) per_cu = 1;
    grid_blocks = cus * per_cu;
  }
  (void)hipMemsetAsync(p.bar, 0, XCD_BAR_WORDS * 4, stream);
#if ONE_LAUNCH
  int lo = 0, hi = N_PHASES;
  void* args[] = {&p, &lo, &hi};
  hipError_t e = hipLaunchCooperativeKernel((void*)mega, dim3(grid_blocks), dim3(512), args, 0, stream);
  if (e != hipSuccess) fprintf(stderr, "cooperative launch failed: %s (grid %d)\n", hipGetErrorString(e), grid_blocks);
#else
  for (int ph = 0; ph < N_PHASES; ++ph) {
    hipLaunchKernelGGL(mega, dim3(grid_blocks), dim3(512), 0, stream, p, ph, ph + 1);
  }
#endif
}
```
